# Optimizing an MI355X kernel written in HIP

```python
import math
import jax, jax.numpy as jnp
from jax import lax
import numpy as np

D_MODEL = 1024
BATCH = 16
SEQ = 2048
DEPTH = 2

N_META = 16
N_A_LAYERS = DEPTH // 2
N_B_LAYERS = DEPTH - N_A_LAYERS
CONV_WIDTH = 3
DIFF_HEAD_DIM = 64
N_DIFF_HEADS = D_MODEL // (2 * DIFF_HEAD_DIM)
DIFF_WIDTH = N_DIFF_HEADS * 2 * DIFF_HEAD_DIM
Q_BLOCK = 128
N_GROUPS = 4
EXPERTS_PER_GROUP = 4
N_EXPERTS = N_GROUPS * EXPERTS_PER_GROUP
TOP_K_IN_GROUP = 2
D_EXPERT = D_MODEL // 2
RMS_EPS = 1e-6
SUBLN_EPS = 1e-5

kernel_name = 'yoco_shortconv_diffattn_hmoe'


def rmsnorm(x, g, eps=RMS_EPS):
    xf = x.astype(jnp.float32)
    y = xf * lax.rsqrt(jnp.mean(xf * xf, axis=-1, keepdims=True) + eps)
    return (y * g.astype(jnp.float32)).astype(x.dtype)


def short_conv_mixer(xn, w_in, conv_w, w_out):
    bcu = xn @ w_in
    b, c, u = jnp.split(bcu, 3, axis=-1)
    z = c * u
    conv = lax.conv_general_dilated(
        z, conv_w[:, None, :], window_strides=(1,), padding=[(CONV_WIDTH - 1, 0)],
        dimension_numbers=('NWC', 'WIO', 'NWC'), feature_group_count=D_MODEL)
    return (b * conv) @ w_out


def lambda_init_for(layer_idx):
    return 0.8 - 0.6 * math.exp(-0.3 * layer_idx)


def diff_attention(xn, k, v, w_q, lam, subln_g, w_o, lambda_init):
    bsz, seq_len, _ = xn.shape
    lp = k.shape[1]
    n_blocks = lp // Q_BLOCK
    q = (xn @ w_q).reshape(bsz, seq_len, N_DIFF_HEADS, 2, DIFF_HEAD_DIM)
    q = jnp.pad(q, ((0, 0), (0, lp - seq_len), (0, 0), (0, 0), (0, 0)))
    q_blocks = q.reshape(bsz, n_blocks, Q_BLOCK, N_DIFF_HEADS, 2, DIFF_HEAD_DIM).transpose(1, 0, 2, 3, 4, 5)
    lam_f = lam.astype(jnp.float32)
    lambda_full = jnp.exp(jnp.sum(lam_f[0] * lam_f[1])) - jnp.exp(jnp.sum(lam_f[2] * lam_f[3])) + lambda_init
    key_pos = jnp.arange(lp)
    scale = DIFF_HEAD_DIM ** -0.5

    def one_block(args):
        qb, start = args
        s = jnp.einsum('bqhcd,bkhcd->bhcqk', qb, k).astype(jnp.float32) * scale
        q_pos = start + jnp.arange(Q_BLOCK)
        mask = key_pos[None, :] <= q_pos[:, None]
        s = jnp.where(mask, s, -jnp.inf)
        p = jax.nn.softmax(s, axis=-1)
        a = p[:, :, 0] - lambda_full * p[:, :, 1]
        return jnp.einsum('bhqk,bkhe->bqhe', a.astype(v.dtype), v)

    starts = jnp.arange(n_blocks) * Q_BLOCK
    o = lax.map(one_block, (q_blocks, starts))
    o = o.transpose(1, 0, 2, 3, 4).reshape(bsz, lp, N_DIFF_HEADS, 2 * DIFF_HEAD_DIM)[:, :seq_len]
    o = rmsnorm(o, subln_g, SUBLN_EPS) * (1.0 - lambda_init)
    return o.reshape(bsz, seq_len, DIFF_WIDTH) @ w_o


def hier_moe(xn, w_rg, b_rg, w_re, b_re, w_gate, w_up, w_down):
    bsz, seq_len, d = xn.shape
    t = xn.reshape(-1, d)
    lg = (t @ w_rg).astype(jnp.float32) + b_rg.astype(jnp.float32)
    pg = jax.nn.softmax(lg, axis=-1)
    g_idx = jnp.argmax(lg, axis=-1)
    p_sel = jnp.take_along_axis(pg, g_idx[:, None], axis=-1)[:, 0]
    le = ((t @ w_re).astype(jnp.float32) + b_re.astype(jnp.float32)).reshape(-1, N_GROUPS, EXPERTS_PER_GROUP)
    le_sel = jnp.take_along_axis(le, g_idx[:, None, None], axis=1)[:, 0]
    top_v, top_i = lax.top_k(le_sel, TOP_K_IN_GROUP)
    w_k = jax.nn.softmax(top_v, axis=-1) * p_sel[:, None]
    within = jnp.sum(jax.nn.one_hot(top_i, EXPERTS_PER_GROUP, dtype=jnp.float32) * w_k[..., None], axis=1)
    combine = (jax.nn.one_hot(g_idx, N_GROUPS, dtype=jnp.float32)[:, :, None] * within[:, None, :])
    combine = combine.reshape(-1, N_EXPERTS).astype(t.dtype)
    y = jnp.zeros_like(t)
    for e in range(N_EXPERTS):
        h = jax.nn.silu(t @ w_gate[e]) * (t @ w_up[e])
        y = y + (h * combine[:, e:e + 1]) @ w_down[e]
    return y.reshape(bsz, seq_len, d)


def setup_inputs(seed: int = 0) -> dict:
    key = jax.random.key(seed)
    ks = jax.random.split(key, 24)
    f32 = jnp.float32
    nrm = lambda k, shape, s: jax.random.normal(k, shape, f32) * s
    gain = lambda k, shape: 1.0 + 0.02 * jax.random.normal(k, shape, f32)
    D = D_MODEL
    return {
        'x': nrm(ks[0], (BATCH, SEQ, D), 1.0),
        'meta_tokens': nrm(ks[1], (N_META, D), 1.0),
        'a_norm': gain(ks[2], (N_A_LAYERS, D)),
        'a_w_in': nrm(ks[3], (N_A_LAYERS, D, 3 * D), D ** -0.5),
        'a_conv': nrm(ks[4], (N_A_LAYERS, CONV_WIDTH, D), CONV_WIDTH ** -0.5),
        'a_w_out': nrm(ks[5], (N_A_LAYERS, D, D), D ** -0.5),
        'kv_norm': gain(ks[6], (D,)),
        'w_kv': nrm(ks[7], (D, 2 * DIFF_WIDTH), D ** -0.5),
        'b_norm': gain(ks[8], (N_B_LAYERS, D)),
        'b_w_q': nrm(ks[9], (N_B_LAYERS, D, DIFF_WIDTH), D ** -0.5),
        'b_lambda': nrm(ks[10], (N_B_LAYERS, 4, DIFF_HEAD_DIM), 0.1),
        'b_subln': gain(ks[11], (N_B_LAYERS, 2 * DIFF_HEAD_DIM)),
        'b_w_o': nrm(ks[12], (N_B_LAYERS, DIFF_WIDTH, D), DIFF_WIDTH ** -0.5),
        'ffn_norm': gain(ks[13], (DEPTH, D)),
        'router_group_w': nrm(ks[14], (DEPTH, D, N_GROUPS), D ** -0.5),
        'router_group_b': nrm(ks[15], (DEPTH, N_GROUPS), 0.01),
        'router_expert_w': nrm(ks[16], (DEPTH, D, N_EXPERTS), D ** -0.5),
        'router_expert_b': nrm(ks[17], (DEPTH, N_EXPERTS), 0.01),
        'expert_w_gate': nrm(ks[18], (DEPTH, N_EXPERTS, D, D_EXPERT), D ** -0.5),
        'expert_w_up': nrm(ks[19], (DEPTH, N_EXPERTS, D, D_EXPERT), D ** -0.5),
        'expert_w_down': nrm(ks[20], (DEPTH, N_EXPERTS, D_EXPERT, D), D_EXPERT ** -0.5),
        'final_norm': gain(ks[21], (D,)),
    }


def reference(x, meta_tokens, a_norm, a_w_in, a_conv, a_w_out, kv_norm, w_kv, b_norm, b_w_q, b_lambda,
              b_subln, b_w_o, ffn_norm, router_group_w, router_group_b, router_expert_w, router_expert_b,
              expert_w_gate, expert_w_up, expert_w_down, final_norm):
    bsz = x.shape[0]
    meta = jnp.broadcast_to(meta_tokens[None].astype(x.dtype), (bsz, N_META, D_MODEL))
    h = jnp.concatenate([meta, x], axis=1)
    seq_len = h.shape[1]
    lp = ((seq_len + Q_BLOCK - 1) // Q_BLOCK) * Q_BLOCK
    k_shared = None
    v_shared = None
    for layer in range(DEPTH):
        if layer < N_A_LAYERS:
            i = layer
            h = h + short_conv_mixer(rmsnorm(h, a_norm[i]), a_w_in[i], a_conv[i], a_w_out[i])
        else:
            j = layer - N_A_LAYERS
            if j == 0:
                kv = rmsnorm(h, kv_norm) @ w_kv
                k_part, v_part = jnp.split(kv, 2, axis=-1)
                k_shared = k_part.reshape(bsz, seq_len, N_DIFF_HEADS, 2, DIFF_HEAD_DIM)
                v_shared = v_part.reshape(bsz, seq_len, N_DIFF_HEADS, 2 * DIFF_HEAD_DIM)
                k_shared = jnp.pad(k_shared, ((0, 0), (0, lp - seq_len), (0, 0), (0, 0), (0, 0)))
                v_shared = jnp.pad(v_shared, ((0, 0), (0, lp - seq_len), (0, 0), (0, 0)))
            h = h + diff_attention(rmsnorm(h, b_norm[j]), k_shared, v_shared, b_w_q[j], b_lambda[j],
                                   b_subln[j], b_w_o[j], lambda_init_for(layer))
        h = h + hier_moe(rmsnorm(h, ffn_norm[layer]), router_group_w[layer], router_group_b[layer],
                         router_expert_w[layer], router_expert_b[layer], expert_w_gate[layer],
                         expert_w_up[layer], expert_w_down[layer])
    return rmsnorm(h, final_norm)[:, N_META:]
```

```cpp
#include <hip/hip_runtime.h>
#include <cstdio>
#include <cstdint>

#define GAS __attribute__((address_space(1)))
#define LAS __attribute__((address_space(3)))
typedef unsigned short bf16_t;
typedef short bf16x8 __attribute__((ext_vector_type(8)));
typedef float f32x4 __attribute__((ext_vector_type(4)));
typedef float f32x16 __attribute__((ext_vector_type(16)));
typedef unsigned u32x4 __attribute__((ext_vector_type(4)));
typedef unsigned u32x2 __attribute__((ext_vector_type(2)));

constexpr int D = 1024, BATCH = 16, SEQ = 2048, NMETA = 16;
constexpr int MMAIN = BATCH * SEQ;
constexpr int META0 = MMAIN;
constexpr int NTOK0 = MMAIN + NMETA;
constexpr int R = MMAIN + 256;
constexpr int ZROW = NTOK0;
constexpr int NCLS = 24, NEXP = 16, DE = 512;
constexpr float RMS_EPS = 1e-6f, SUBLN_EPS = 1e-5f;
constexpr float LOG2E = 1.4426950408889634f;
constexpr float QSCALE = 0.125f * LOG2E;
constexpr int NWAVES = 8, NTHR = 512;
#ifndef FP8_M1_MASK
#define FP8_M1_MASK 3
#endif
#ifndef FP8_MASK
#define FP8_MASK 3
#endif
constexpr float SA8 = 4.f, SW8 = 64.f, SH8 = 8.f, SWD8 = 32.f;

constexpr size_t MiB = 1u << 20;
constexpr size_t WS_CTL = 0, CTL_BYTES = 1 * MiB;
constexpr size_t WS_WIN = 1 * MiB;
constexpr size_t WS_WOUT = 7 * MiB;
constexpr size_t WS_WKVQ = 9 * MiB;
constexpr size_t WS_WO = 15 * MiB;
constexpr size_t WS_WEXP = 17 * MiB;
constexpr size_t WS_WR = 113 * MiB;
constexpr size_t WS_HMETA = 114 * MiB;
constexpr size_t WS_MISC = 115 * MiB;
constexpr size_t WS_HB = 123 * MiB;
constexpr size_t WS_H = 188 * MiB;
constexpr size_t WS_X = 265 * MiB;
constexpr size_t ROWBUF = (size_t)R * D * 2;
constexpr size_t WS_HB8 = 459 * MiB;
constexpr size_t WS_END = WS_HB8 + (size_t)R * D;
static_assert(WS_END <= 512 * MiB, "workspace");
constexpr size_t MISC_RSTD = 0;
constexpr size_t MISC_TOKW = 1 * MiB;
constexpr size_t MISC_TOKC = 1 * MiB + 512 * 1024;
constexpr size_t MISC_LIST = 2 * MiB;
constexpr size_t MISC_SSQ = 5 * MiB + 512 * 1024;
constexpr int CW_BAR = 4096;
constexpr int CW_CNT0 = 16384, CW_CNT1 = 16384 + 64 * 32;
constexpr int CW_SSQ = 131072;

__device__ __forceinline__ float bf2f(unsigned v) { return __uint_as_float(v << 16); }
__device__ __forceinline__ float bflo(unsigned v) { return __uint_as_float(v << 16); }
__device__ __forceinline__ float bfhi(unsigned v) { return __uint_as_float(v & 0xffff0000u); }
__device__ __forceinline__ unsigned pk2(float lo, float hi) { unsigned r; asm("v_cvt_pk_bf16_f32 %0, %1, %2" : "=v"(r) : "v"(lo), "v"(hi)); return r; }
__device__ __forceinline__ bf16_t f2bf(float f) { return (bf16_t)(pk2(f, 0.f) & 0xffffu); }
__device__ __forceinline__ int olane() { unsigned z = 0u; asm volatile("" : "+v"(z)); return (int)__builtin_amdgcn_mbcnt_hi(~0u, __builtin_amdgcn_mbcnt_lo(~0u, z)); }
__device__ __forceinline__ unsigned pk4_fp8(float a, float b, float c, float d) { int p = __builtin_amdgcn_cvt_pk_fp8_f32(a, b, 0, false); p = __builtin_amdgcn_cvt_pk_fp8_f32(c, d, p, true); return (unsigned)p; }
__device__ __forceinline__ float wave_sum(float v) {
#pragma unroll
    for (int o = 1; o < 64; o <<= 1) v += __shfl_xor(v, o);
    return v;
}
__device__ __forceinline__ float wave_max(float v) {
#pragma unroll
    for (int o = 1; o < 64; o <<= 1) v = fmaxf(v, __shfl_xor(v, o));
    return v;
}
__device__ __forceinline__ int crow(int r, int hi) { return (r & 3) + 8 * (r >> 2) + 4 * hi; }
__host__ __device__ __forceinline__ float lambda_init1() { return 0.8f - 0.6f * 0.7408182206817179f; }

#define XB_TMO      128
#define XB_XCNT(j)  (256  + 64 * (j))
#define XB_XSUB(j)  (1280 + 64 * (j))
#define XB_XGEN(j)  (2304 + 64 * (j))
#define XB_TOP      3328
#define XB_TOPGEN   3392
#define XCD_BAR_WORDS 3456
#define XB_SPIN_CAP (1u << 22)
__device__ __forceinline__ unsigned xb_ld(unsigned* p)              { return __hip_atomic_load(p, __ATOMIC_RELAXED, __HIP_MEMORY_SCOPE_AGENT); }
__device__ __forceinline__ unsigned xb_add(unsigned* p, unsigned v) { return __hip_atomic_fetch_add(p, v, __ATOMIC_RELAXED, __HIP_MEMORY_SCOPE_AGENT); }
__device__ __forceinline__ unsigned xb_xcc_id() { return (unsigned)__builtin_amdgcn_s_getreg((3 << 11) | 20) & 0xFu; }
#define XB_SPIN(cond, bar) do { unsigned _sp = 0; while (cond) { __builtin_amdgcn_s_sleep(1); \
    if ((++_sp & 255u) == 0u) { if (xb_ld(&(bar)[XB_TMO])) break; if (_sp > XB_SPIN_CAP) { atomicAdd(&(bar)[XB_TMO], 1u); break; } } } } while (0)
struct XcdBarrier { unsigned* bar; unsigned x; volatile LAS unsigned* st; };
__device__ __forceinline__ XcdBarrier xcd_barrier_post(unsigned* bar, volatile LAS unsigned* st) {
    XcdBarrier b; b.bar = bar; b.x = xb_xcc_id(); b.st = st;
    if (threadIdx.x == 0) (void)xb_add(&bar[XB_XCNT(b.x)], 1u);
    return b;
}
__device__ __forceinline__ void xcd_barrier_complete(unsigned* bar, unsigned x, unsigned& nloc, unsigned& nx) {
    const unsigned G = gridDim.x * gridDim.y * gridDim.z;
    unsigned sum, cnt, mine, sp = 0u;
    for (;;) {
        sum = 0u; cnt = 0u; mine = 0u;
#pragma unroll
        for (unsigned j = 0; j < 16; ++j) { const unsigned c = xb_ld(&bar[XB_XCNT(j)]); sum += c; cnt += (c > 0u) ? 1u : 0u; mine = (j == x) ? c : mine; }
        if (sum == G) break;
        __builtin_amdgcn_s_sleep(1);
        if ((++sp & 255u) == 0u) { if (xb_ld(&bar[XB_TMO])) break; if (sp > XB_SPIN_CAP) { atomicAdd(&bar[XB_TMO], 1u); break; } }
    }
    nloc = mine > 0u ? mine : 1u; nx = cnt > 0u ? cnt : 1u;
}
__device__ __forceinline__ void xcd_barrier(const XcdBarrier& b) {
    asm volatile("s_waitcnt vmcnt(0)" ::: "memory");
    __syncthreads();
    if (threadIdx.x == 0) {
        unsigned* bar = b.bar;
        __builtin_amdgcn_s_waitcnt(0);
        unsigned nloc = b.st[0], nx = b.st[1];
        if (nloc == 0u) { xcd_barrier_complete(bar, b.x, nloc, nx); b.st[0] = nloc; b.st[1] = nx; }
        const unsigned old = xb_add(&bar[XB_XSUB(b.x)], 1u);
        const unsigned gen = old / nloc;
        if (old + 1u == (gen + 1u) * nloc) {
            __builtin_amdgcn_fence(__ATOMIC_RELEASE, "agent");
            asm volatile("s_waitcnt vmcnt(0)" ::: "memory");
            const unsigned og = xb_add(&bar[XB_TOP], 1u);
            const unsigned tg = og / nx;
            if (og + 1u == (tg + 1u) * nx) xb_add(&bar[XB_TOPGEN], 1u);
            else XB_SPIN(xb_ld(&bar[XB_TOPGEN]) == tg, bar);
            __builtin_amdgcn_fence(__ATOMIC_ACQUIRE, "agent");
            xb_add(&bar[XB_XGEN(b.x)], 1u);
            asm volatile("s_waitcnt vmcnt(0)" ::: "memory");
        } else {
            XB_SPIN(xb_ld(&bar[XB_XGEN(b.x)]) == gen, bar);
            __builtin_amdgcn_fence(__ATOMIC_ACQUIRE, "agent");
            asm volatile("s_waitcnt vmcnt(0)" ::: "memory");
        }
    }
    __syncthreads();
}

constexpr int LDS_BYTES = 163840;
constexpr int MISC_OFF = 163584;
struct Args { const float* in[22]; float* out; unsigned char* ws; int ph_lo, ph_hi, li, pad; };
struct Frame {
    LAS unsigned char* lds;
    unsigned* ctl;
    int tid, wave, gw, ngw;
    __device__ __forceinline__ int ln() const { return olane(); }
    const float* in[22]; float* out; unsigned char* ws;
    __device__ __forceinline__ bf16_t* wsb(size_t off) const { return (bf16_t*)(ws + off); }
    __device__ __forceinline__ float* hrow(int r) const { return r < MMAIN ? out + (size_t)r * D : (float*)(ws + WS_HMETA) + (size_t)(r - MMAIN) * D; }
    __device__ __forceinline__ float* rstd(int i) const { return (float*)(ws + WS_MISC + MISC_RSTD + (size_t)i * 262144); }
    __device__ __forceinline__ float* tokw() const { return (float*)(ws + WS_MISC + MISC_TOKW); }
    __device__ __forceinline__ int* tokc() const { return (int*)(ws + WS_MISC + MISC_TOKC); }
    __device__ __forceinline__ int* list() const { return (int*)(ws + WS_MISC + MISC_LIST); }
    __device__ __forceinline__ bf16_t* wexp(int l, int e, int which) const { return (bf16_t*)(ws + WS_WEXP + ((size_t)((l * 16 + e) * 3 + which)) * MiB); }
};
enum { I_X = 0, I_META, I_ANORM, I_WIN, I_CONV, I_WOUT, I_KVNORM, I_WKV, I_BNORM, I_WQ, I_LAMBDA, I_SUBLN, I_WO, I_FFNNORM, I_RGW, I_RGB, I_REW, I_REB, I_WG, I_WU, I_WD, I_FNORM };

__device__ __forceinline__ int win_row(int n) {
    if (n < 1024) return n;
    if (n < 2048) { const int j = n - 1024; return 1024 + (j >> 7) * 256 + (j & 127); }
    const int j = n - 2048; return 1024 + (j >> 7) * 256 + 128 + (j & 127);
}
struct TrJob { const float* W; const float* gain; bf16_t* WT; int K, N, gmask, row_off, mode, item, f8; float gscale; };
__device__ __forceinline__ TrJob tr_decode(Frame& F, int it) {
    constexpr int IT_EXP = 96 * 256, IT_WIN = 16 * 96, IT_WOUT = 16 * 32, IT_WKV = 16 * 64, IT_WQ = 16 * 32;
    TrJob j; j.gain = nullptr; j.gmask = 1023; j.row_off = 0; j.mode = 0; j.gscale = 1.f; j.f8 = 0; int r = it;
    if (r < IT_EXP) { const int m = r >> 8, l = m / 48, e = (m % 48) / 3, which = m % 3; j.item = r & 255;
        if (which == 2) { j.W = F.in[I_WD] + (size_t)(l * 16 + e) * DE * D; j.K = DE; j.N = D; }
        else { j.W = (which == 0 ? F.in[I_WG] : F.in[I_WU]) + (size_t)(l * 16 + e) * D * DE; j.K = D; j.N = DE; j.gain = F.in[I_FFNNORM] + l * D; }
        j.WT = F.wexp(l, e, which); if (which == 2 ? ((FP8_MASK >> l) & 1) : ((FP8_M1_MASK >> l) & 1)) { j.f8 = 1; j.gscale = which == 2 ? SWD8 : SW8; } return j; }
    r -= IT_EXP;
    if (r < IT_WIN) { j.W = F.in[I_WIN]; j.K = D; j.N = 3 * D; j.gain = F.in[I_ANORM]; j.WT = F.wsb(WS_WIN); j.mode = 1; j.item = r; return j; } r -= IT_WIN;
    if (r < IT_WOUT) { j.W = F.in[I_WOUT]; j.K = D; j.N = D; j.WT = F.wsb(WS_WOUT); j.item = r; return j; } r -= IT_WOUT;
    if (r < IT_WKV) { j.W = F.in[I_WKV]; j.K = D; j.N = 2 * D; j.gain = F.in[I_KVNORM]; j.WT = F.wsb(WS_WKVQ); j.item = r; return j; } r -= IT_WKV;
    if (r < IT_WQ) { j.W = F.in[I_WQ]; j.K = D; j.N = D; j.gain = F.in[I_BNORM]; j.WT = F.wsb(WS_WKVQ); j.row_off = 2 * D; j.item = r; return j; } r -= IT_WQ;
    j.W = F.in[I_WO]; j.K = D; j.N = D; j.gain = F.in[I_SUBLN]; j.gmask = 127; j.gscale = 1.f - lambda_init1(); j.WT = F.wsb(WS_WO); j.item = r; return j;
}
__device__ __forceinline__ void tr_load(const TrJob& j, float (&v)[32], int lane) {
    const int nblk = j.N / 32, kb = j.item / nblk, nb = j.item % nblk;
    const float* src = j.W + (size_t)(64 * kb + (lane >> 5)) * j.N + 32 * nb + (lane & 31);
#pragma unroll
    for (int i = 0; i < 32; ++i) v[i] = src[(size_t)(2 * i) * j.N];
}
__device__ __forceinline__ void tr_to_lds(const float (&v)[32], LAS float* scr, int lane) {
#pragma unroll
    for (int i = 0; i < 32; ++i) scr[(2 * i + (lane >> 5)) * 33 + (lane & 31)] = v[i];
}
__device__ __forceinline__ void tr_store(const TrJob& j, LAS float* scr, int lane) {
    const int nblk = j.N / 32, kb = j.item / nblk, nb = j.item % nblk, k0 = 64 * kb, n0 = 32 * nb;
    const int c = lane & 7;
    float g[8];
#pragma unroll
    for (int i = 0; i < 8; ++i) g[i] = (j.gain ? j.gain[(k0 + 8 * c + i) & j.gmask] : 1.f) * j.gscale;
#pragma unroll
    for (int q = 0; q < 4; ++q) { const int n = (lane >> 3) + 8 * q; const LAS float* s = scr + (8 * c) * 33 + n;
        const int nn = n0 + n; const int drow = (j.mode == 1) ? win_row(nn) : j.row_off + nn;
        if (j.f8) { u32x2 o; o.x = pk4_fp8(s[0 * 33] * g[0], s[1 * 33] * g[1], s[2 * 33] * g[2], s[3 * 33] * g[3]); o.y = pk4_fp8(s[4 * 33] * g[4], s[5 * 33] * g[5], s[6 * 33] * g[6], s[7 * 33] * g[7]);
            *(u32x2*)((unsigned char*)j.WT + (size_t)drow * j.K + k0 + 8 * c) = o; }
        else { u32x4 o; o.x = pk2(s[0 * 33] * g[0], s[1 * 33] * g[1]); o.y = pk2(s[2 * 33] * g[2], s[3 * 33] * g[3]); o.z = pk2(s[4 * 33] * g[4], s[5 * 33] * g[5]); o.w = pk2(s[6 * 33] * g[6], s[7 * 33] * g[7]);
            *(u32x4*)(j.WT + (size_t)drow * j.K + k0 + 8 * c) = o; } }
}
__device__ __forceinline__ void p0_prologue(Frame& F) {
    LAS float* scr = (LAS float*)(F.lds + F.wave * 16384);
    constexpr int NITEMS = 96 * 256 + 16 * 96 + 16 * 32 + 16 * 64 + 16 * 32 + 16 * 32;
    { float v[32]; int it = F.gw; TrJob cur; if (it < NITEMS) { cur = tr_decode(F, it); tr_load(cur, v, F.ln()); }
      while (it < NITEMS) {
          tr_to_lds(v, scr, F.ln());
          const int nx = it + F.ngw; TrJob nj; if (nx < NITEMS) { nj = tr_decode(F, nx); tr_load(nj, v, F.ln()); }
          asm volatile("s_waitcnt lgkmcnt(0)" ::: "memory");
          tr_store(cur, scr, F.ln());
          asm volatile("s_waitcnt lgkmcnt(0)" ::: "memory");
          cur = nj; it = nx; } }
    { u32x4* wrf = (u32x4*)(F.ws + WS_WR);
      for (int idx = F.gw * 64 + F.ln(); idx < 2 * 32 * 2 * 64; idx += F.ngw * 64) { const int l = idx >> 12, s = (idx >> 7) & 31, cb = (idx >> 6) & 1, ln = idx & 63; const int col = cb * 16 + (ln & 15), kq = ln >> 4;
          float w[8];
#pragma unroll
          for (int e = 0; e < 8; ++e) { const int k = 32 * s + 8 * kq + e; float v = 0.f;
              if (col < 20) v = F.in[I_FFNNORM][l * D + k] * ((col < 4) ? F.in[I_RGW][(size_t)(l * D + k) * 4 + col] : F.in[I_REW][(size_t)(l * D + k) * 16 + (col - 4)]);
              w[e] = v; }
          const u32x4 hi = (u32x4){pk2(w[0], w[1]), pk2(w[2], w[3]), pk2(w[4], w[5]), pk2(w[6], w[7])};
          const u32x4 lo = (u32x4){pk2(w[0] - bflo(hi.x), w[1] - bfhi(hi.x)), pk2(w[2] - bflo(hi.y), w[3] - bfhi(hi.y)), pk2(w[4] - bflo(hi.z), w[5] - bfhi(hi.z)), pk2(w[6] - bflo(hi.w), w[7] - bfhi(hi.w))};
          u32x4* dst = wrf + (size_t)l * 8192 + ((s * 2 + cb) * 2) * 64 + ln; dst[0] = hi; dst[64] = lo; } }
    bf16_t* hb = F.wsb(WS_HB); float* rs = F.rstd(0);
    for (int r = F.gw; r < R; r += F.ngw) {
        GAS unsigned long long* o8 = (GAS unsigned long long*)(hb + (size_t)r * D) + F.ln();
        if (r >= NTOK0) {
            if (FP8_M1_MASK) ((GAS u32x4*)(F.ws + WS_HB8 + (size_t)r * D))[F.ln()] = (u32x4){0u, 0u, 0u, 0u};
#pragma unroll
            for (int j = 0; j < 4; ++j) o8[64 * j] = 0ull;
            if (F.ln() == 0) rs[r] = 0.f;
            continue;
        }
        const float* src = r < MMAIN ? F.in[I_X] + (size_t)r * D : F.in[I_META] + (size_t)(r - MMAIN) * D;
        const GAS f32x4* xr = (const GAS f32x4*)src + F.ln();
        f32x4 v[4]; float s = 0.f;
#pragma unroll
        for (int j = 0; j < 4; ++j) { v[j] = xr[64 * j]; s += (v[j].x * v[j].x + v[j].y * v[j].y) + (v[j].z * v[j].z + v[j].w * v[j].w); }
        s = wave_sum(s);
#pragma unroll
        for (int j = 0; j < 4; ++j) o8[64 * j] = (unsigned long long)pk2(v[j].x, v[j].y) | ((unsigned long long)pk2(v[j].z, v[j].w) << 32);
        if (F.ln() == 0) rs[r] = 1.0f / sqrtf(s * (1.f / D) + RMS_EPS);
    }
}

__device__ __forceinline__ void p2_conv(Frame& F) {
    const bf16_t* Bb = F.wsb(WS_X); const bf16_t* Zb = F.wsb(WS_X + ROWBUF); bf16_t* G = F.wsb(WS_X + 2 * ROWBUF); const float* cw = F.in[I_CONV];
    const int tid = F.wave * 64 + F.ln(); const int c8 = (tid & 127) * 8, rsub = tid >> 7;
    float w0[8], w1[8], w2[8];
#pragma unroll
    for (int q = 0; q < 2; ++q) { const f32x4 a = *(const f32x4*)(cw + c8 + 4 * q), b = *(const f32x4*)(cw + D + c8 + 4 * q), c = *(const f32x4*)(cw + 2 * D + c8 + 4 * q);
#pragma unroll
        for (int e = 0; e < 4; ++e) { w0[4 * q + e] = a[e]; w1[4 * q + e] = b[e]; w2[4 * q + e] = c[e]; } }
    const int nblk = R / 8;
    for (int blk = blockIdx.x * 4 + rsub; blk < nblk; blk += gridDim.x * 4) {
        const int r0 = blk * 8;
        if (r0 >= NTOK0) {
#pragma unroll
            for (int i = 0; i < 8; ++i) *(u32x4*)(G + (size_t)(r0 + i) * D + c8) = (u32x4){0u, 0u, 0u, 0u};
            continue; }
        int p1, p2;
        if (r0 < MMAIN) { const int s = r0 & (SEQ - 1); p1 = s >= 1 ? r0 - 1 : META0 + 15; p2 = s >= 2 ? r0 - 2 : META0 + 14; }
        else { p1 = r0 > META0 ? r0 - 1 : -1; p2 = r0 > META0 ? r0 - 2 : -1; }
        u32x4 zm2 = p2 >= 0 ? *(const u32x4*)(Zb + (size_t)p2 * D + c8) : (u32x4){0u, 0u, 0u, 0u};
        u32x4 zm1 = p1 >= 0 ? *(const u32x4*)(Zb + (size_t)p1 * D + c8) : (u32x4){0u, 0u, 0u, 0u};
        u32x4 zr[8], br[8];
#pragma unroll
        for (int i = 0; i < 8; ++i) { zr[i] = *(const u32x4*)(Zb + (size_t)(r0 + i) * D + c8); br[i] = *(const u32x4*)(Bb + (size_t)(r0 + i) * D + c8); }
#pragma unroll
        for (int i = 0; i < 8; ++i) { const u32x4 z0 = zr[i], z1 = i >= 1 ? zr[i - 1] : zm1, z2 = i >= 2 ? zr[i - 2] : (i == 1 ? zm1 : zm2); const u32x4 bv = br[i];
            float g[8];
#pragma unroll
            for (int q = 0; q < 4; ++q) {
                g[2 * q] = bflo(bv[q]) * (w0[2 * q] * bflo(z2[q]) + w1[2 * q] * bflo(z1[q]) + w2[2 * q] * bflo(z0[q]));
                g[2 * q + 1] = bfhi(bv[q]) * (w0[2 * q + 1] * bfhi(z2[q]) + w1[2 * q + 1] * bfhi(z1[q]) + w2[2 * q + 1] * bfhi(z0[q])); }
            *(u32x4*)(G + (size_t)(r0 + i) * D + c8) = (u32x4){pk2(g[0], g[1]), pk2(g[2], g[3]), pk2(g[4], g[5]), pk2(g[6], g[7])}; }
    }
}
__device__ __forceinline__ void cls_experts(int cls, int& elo, int& ehi) { const int g = cls / 6, p = cls % 6; const int lo = p < 3 ? 0 : (p < 5 ? 1 : 2), hi = p < 3 ? p + 1 : (p < 5 ? p - 1 : 3); elo = 4 * g + lo; ehi = 4 * g + hi; }
__device__ __forceinline__ float silu(float g) { return g / (1.f + __expf(-g)); }

constexpr int RT_SCR = 131072, RT_HIST = RT_SCR + 8 * 1536;
__device__ __forceinline__ void p_router(Frame& F, int layer, int ntok, float* rstd_out, unsigned* cnt, bool dry) {
    const u32x4* wrf = (const u32x4*)(F.ws + WS_WR) + (size_t)layer * 8192;
    const float* bg = F.in[I_RGB] + layer * 4; const float* be = F.in[I_REB] + layer * 16;
    float* tw = F.tokw(); int* lst = F.list();
    LAS u32x4* bfr = (LAS u32x4*)F.lds;
    { u32x4 tmp[16];
#pragma unroll
      for (int i = 0; i < 16; ++i) tmp[i] = wrf[F.tid + 512 * i];
#pragma unroll
      for (int i = 0; i < 16; ++i) bfr[F.tid + 512 * i] = tmp[i]; }
    LAS int* hist = (LAS int*)(F.lds + RT_HIST);
    LAS float* scr = (LAS float*)(F.lds + RT_SCR + F.wave * 1536);
    const bf16_t* hb = F.wsb(WS_HB);
    const int ntiles = (ntok + 127) >> 7;
    for (int tile = blockIdx.x; tile < ntiles; tile += gridDim.x) {
        __syncthreads();
        if (F.tid < 64) hist[F.tid] = 0;
        __syncthreads();
        const int row = tile * 128 + F.wave * 16 + (F.ln() & 15); const bool rvalid = row < ntok; const int kq = F.ln() >> 4;
        const u32x4* ap = (const u32x4*)(hb + (size_t)(rvalid ? row : ZROW) * D) + kq;
        u32x4 a[32];
#pragma unroll
        for (int s = 0; s < 32; ++s) a[s] = ap[4 * s];
        f32x4 acc0 = (f32x4){0.f, 0.f, 0.f, 0.f}, acc1 = acc0; float ss = 0.f;
#pragma unroll
        for (int s = 0; s < 32; ++s) {
            const LAS u32x4* bp = bfr + (s * 4) * 64 + F.ln();
            const bf16x8 av = __builtin_bit_cast(bf16x8, a[s]);
            acc0 = __builtin_amdgcn_mfma_f32_16x16x32_bf16(av, __builtin_bit_cast(bf16x8, bp[0]), acc0, 0, 0, 0);
            acc1 = __builtin_amdgcn_mfma_f32_16x16x32_bf16(av, __builtin_bit_cast(bf16x8, bp[128]), acc1, 0, 0, 0);
            acc0 = __builtin_amdgcn_mfma_f32_16x16x32_bf16(av, __builtin_bit_cast(bf16x8, bp[64]), acc0, 0, 0, 0);
            acc1 = __builtin_amdgcn_mfma_f32_16x16x32_bf16(av, __builtin_bit_cast(bf16x8, bp[192]), acc1, 0, 0, 0);
#pragma unroll
            for (int q = 0; q < 4; ++q) { const float x0 = bflo(a[s][q]), x1 = bfhi(a[s][q]); ss += x0 * x0 + x1 * x1; }
        }
        ss += __shfl_xor(ss, 16); ss += __shfl_xor(ss, 32);
#pragma unroll
        for (int r = 0; r < 4; ++r) { scr[(4 * kq + r) * 24 + (F.ln() & 15)] = acc0[r]; if ((F.ln() & 15) < 8) scr[(4 * kq + r) * 24 + 16 + (F.ln() & 15)] = acc1[r]; }
        asm volatile("s_waitcnt lgkmcnt(0)" ::: "memory");
        int cls = 0, slot = 0; float rstd = 0.f, wlo = 0.f, whi = 0.f;
        const bool router_lane = F.ln() < 16 && rvalid;
        if (router_lane) {
            rstd = 1.0f / sqrtf(ss * (1.f / D) + RMS_EPS);
            float dt[20];
#pragma unroll
            for (int q = 0; q < 20; ++q) dt[q] = scr[F.ln() * 24 + q] * rstd;
            float lg[4];
#pragma unroll
            for (int q = 0; q < 4; ++q) lg[q] = dt[q] + bg[q];
            int g = 0; float mg = lg[0];
#pragma unroll
            for (int q = 1; q < 4; ++q) if (lg[q] > mg) { mg = lg[q]; g = q; }
            float den = 0.f;
#pragma unroll
            for (int q = 0; q < 4; ++q) den += __expf(lg[q] - mg);
            const float psel = 1.0f / den;
            float le[4];
#pragma unroll
            for (int q = 0; q < 4; ++q) { const float d0 = dt[4 + q] + be[q], d1 = dt[8 + q] + be[4 + q], d2 = dt[12 + q] + be[8 + q], d3 = dt[16 + q] + be[12 + q];
                le[q] = g == 0 ? d0 : (g == 1 ? d1 : (g == 2 ? d2 : d3)); }
            int i1 = 0; float v1 = le[0];
#pragma unroll
            for (int q = 1; q < 4; ++q) if (le[q] > v1) { v1 = le[q]; i1 = q; }
            int i2 = -1; float v2 = -INFINITY;
#pragma unroll
            for (int q = 0; q < 4; ++q) if (q != i1 && le[q] > v2) { v2 = le[q]; i2 = q; }
            const float e2 = __expf(v2 - v1); const float w1 = psel / (1.f + e2), w2 = psel * e2 / (1.f + e2);
            const int lo = i1 < i2 ? i1 : i2, hi = i1 < i2 ? i2 : i1;
            const int pidx = lo == 0 ? hi - 1 : (lo == 1 ? hi + 1 : 5);
            cls = g * 6 + pidx; wlo = i1 < i2 ? w1 : w2; whi = i1 < i2 ? w2 : w1;
            slot = __hip_atomic_fetch_add((int*)(hist + cls), 1, __ATOMIC_RELAXED, __HIP_MEMORY_SCOPE_WORKGROUP);
        }
        __syncthreads();
        if (F.tid < NCLS && !dry) { const int n = hist[F.tid]; hist[32 + F.tid] = n ? (int)atomicAdd(cnt + 64 * F.tid, (unsigned)n) : 0; }
        __syncthreads();
        if (router_lane && !dry) { const int pos = hist[32 + cls] + slot; lst[(size_t)cls * R + pos] = row; rstd_out[row] = rstd; tw[2 * row] = wlo; tw[2 * row + 1] = whi; }
    }
    __syncthreads();
}
__device__ __forceinline__ void p_rowstat(Frame& F, float* rstd_out) {
    const bf16_t* hb = F.wsb(WS_HB);
    for (int r = F.gw; r < R; r += F.ngw) {
        const u32x4* xr = (const u32x4*)(hb + (size_t)r * D) + F.ln(); const u32x4 a = xr[0], b = xr[64]; float s = 0.f;
#pragma unroll
        for (int q = 0; q < 4; ++q) { s += bflo(a[q]) * bflo(a[q]) + bfhi(a[q]) * bfhi(a[q]); s += bflo(b[q]) * bflo(b[q]) + bfhi(b[q]) * bfhi(b[q]); }
        s = wave_sum(s);
        if (F.ln() == 0) rstd_out[r] = 1.0f / sqrtf(s * (1.f / D) + RMS_EPS);
    }
}
__device__ __forceinline__ float lambda_full(Frame& F) {
    const float* lm = F.in[I_LAMBDA]; const int l = F.ln();
    const float a = wave_sum(lm[l] * lm[64 + l]), b = wave_sum(lm[128 + l] * lm[192 + l]);
    return __expf(a) - __expf(b) + lambda_init1();
}
__device__ __forceinline__ void p_final(Frame& F, bool dry) {
    const bf16_t* hb = F.wsb(WS_HB); const float* gn = F.in[I_FNORM];
    const f32x4 g0 = *(const f32x4*)(gn + 8 * F.ln()), g1 = *(const f32x4*)(gn + 8 * F.ln() + 4), g2 = *(const f32x4*)(gn + 512 + 8 * F.ln()), g3 = *(const f32x4*)(gn + 512 + 8 * F.ln() + 4);
    for (int r = F.gw; r < MMAIN; r += F.ngw) {
        const u32x4* xr = (const u32x4*)(hb + (size_t)r * D) + F.ln(); const u32x4 a = xr[0], b = xr[64];
        f32x4 v0 = (f32x4){bflo(a.x), bfhi(a.x), bflo(a.y), bfhi(a.y)}, v1 = (f32x4){bflo(a.z), bfhi(a.z), bflo(a.w), bfhi(a.w)};
        f32x4 v2 = (f32x4){bflo(b.x), bfhi(b.x), bflo(b.y), bfhi(b.y)}, v3 = (f32x4){bflo(b.z), bfhi(b.z), bflo(b.w), bfhi(b.w)};
        float s = (v0.x * v0.x + v0.y * v0.y) + (v0.z * v0.z + v0.w * v0.w) + (v1.x * v1.x + v1.y * v1.y) + (v1.z * v1.z + v1.w * v1.w)
                + (v2.x * v2.x + v2.y * v2.y) + (v2.z * v2.z + v2.w * v2.w) + (v3.x * v3.x + v3.y * v3.y) + (v3.z * v3.z + v3.w * v3.w);
        s = wave_sum(s); const float rstd = 1.0f / sqrtf(s * (1.f / D) + RMS_EPS);
        if (!dry) { f32x4* o = (f32x4*)(F.out + (size_t)r * D + 8 * F.ln());
            o[0] = v0 * rstd * g0; o[1] = v1 * rstd * g1; o[128] = v2 * rstd * g2; o[129] = v3 * rstd * g3; }
    }
}

#ifndef GP_SKEW_TICKS
#define GP_SKEW_TICKS 0
#endif
namespace gp {
typedef int v4i32 __attribute__((ext_vector_type(4))); typedef int v8i32 __attribute__((ext_vector_type(8)));
constexpr int BM = 256, BK = 64, HALF = 128, HTB = HALF * BK * 2, STAGE_BYTES = 8 * HTB, NXCD = 8, WGM = 8;
__host__ __device__ __forceinline__ int lds_byte(int r, int c) { const int st = (r >> 4) * 2 + (c >> 5), rr = r & 15, cc = c & 31, ob = rr * 64 + cc * 2; return st * 1024 + (ob ^ (((ob >> 9) & 1) << 5)); }
__host__ __device__ __forceinline__ void stage_rc(int b, int& R_, int& C_) { const int st = b / 1024, sb = b % 1024, swz = sb ^ (((sb >> 9) & 1) << 5); R_ = (st >> 1) * 16 + swz / 64; C_ = (st & 1) * 32 + (swz % 64) / 2; }
__host__ __device__ __forceinline__ int perm32(int rho) { const int n = rho >> 4, i = rho & 15; return 8 * (i >> 2) + 4 * n + (i & 3); }

struct Unit {
    unsigned b0, b1;
    int bd; int ks;
    int pm, pn;
    int x0, x1;
};
__device__ __forceinline__ bool static_order(int i, int G, int c, int nM, int nN, int& pm, int& pn) {
    const int nwg = nM * nN; const int L = i * G + c; if (L >= nwg) return false;
    int wgid = L; { const int q = nwg / NXCD, r = nwg % NXCD, xcd = wgid % NXCD, off = wgid / NXCD; wgid = (xcd < r ? xcd * (q + 1) : r * (q + 1) + (xcd - r) * q) + off; }
    const int nig = WGM * nN, gid = wgid / nig, fm = gid * WGM, gsz = (nM - fm) < WGM ? (nM - fm) : WGM;
    pm = fm + ((wgid % nig) % gsz); pn = (wgid % nig) / gsz; return true;
}
__device__ __forceinline__ void bdma16(__amdgpu_buffer_rsrc_t rs, unsigned voff, unsigned soff, LAS void* l) { __builtin_amdgcn_raw_ptr_buffer_load_lds(rs, l, 16, (int)voff, (int)soff, 0, 0); }

template <class Epi, class Sched, int NT, bool F8 = false, bool ALIGN_EPI = true>
__device__ __forceinline__ void gemm_phase(LAS unsigned char* lds, int wid_in  , unsigned char* ws, unsigned Aoff  , int ldb_bytes  , Sched& S, const Epi& E) {
    constexpr bool GATHER = Sched::GATHER;
    const __amdgpu_buffer_rsrc_t rsrc = __builtin_amdgcn_make_buffer_rsrc((void*)ws, 0, 0x7fffffff, 0x00020000);
    const int wid = wid_in, wr = wid >> 2, wc = wid & 3; const int lane = olane(), tid = wid * 64 + lane, fr = lane & 15, fq = lane >> 4;
    unsigned voffB[2], voffA[2];
#pragma unroll
    for (int i = 0; i < 2; ++i) { int R_, C_; stage_rc(tid * 16 + i * 8192, R_, C_); const int Rb = Epi::PERM ? ((R_ & ~31) + perm32(R_ & 31)) : R_; voffB[i] = (unsigned)(Rb * ldb_bytes + C_ * 2);
        if constexpr (!GATHER) voffA[i] = (unsigned)(R_ * S.a_pitch() + C_ * 2); }
    const unsigned kstep = (unsigned)(BK * 2);
    const unsigned ldsw = (unsigned)wid * 1024u;
    const int aoff = lds_byte(wr * 64 + fr, fq * 8), boff = lds_byte(wc * 32 + fr, fq * 8);
#define GP_SA(b, h) (((b) * 2 + (h)) * HTB)
#define GP_SB(b, h) ((4 + (b) * 2 + (h)) * HTB)
#define GP_STAGE_B(bufoff, gbase) do { bdma16(rsrc, voffB[0], (gbase), lds + (bufoff) + ldsw); bdma16(rsrc, voffB[1], (gbase), lds + (bufoff) + ldsw + 8192); } while (0)
#define GP_STAGE_A(bufoff, h, koff) do { \
        if constexpr (GATHER) { bdma16(rsrc, co[h][0], Aoff + (koff), lds + (bufoff) + ldsw); bdma16(rsrc, co[h][1], Aoff + (koff), lds + (bufoff) + ldsw + 8192); } \
        else { const unsigned g_ = Aoff + cAu[h] + (koff); bdma16(rsrc, voffA[0], g_, lds + (bufoff) + ldsw); bdma16(rsrc, voffA[1], g_, lds + (bufoff) + ldsw + 8192); } } while (0)
#define GP_LDA(dst, b, h) do { if constexpr (F8) { _Pragma("unroll") for (int m = 0; m < 4; ++m) { const v4i32 lo_ = *(const LAS v4i32*)(lds + GP_SA(b, h) + aoff + m * 2048), hi_ = *(const LAS v4i32*)(lds + GP_SA(b, h) + aoff + m * 2048 + 1024); \
            dst##8[m] = __builtin_shufflevector(lo_, hi_, 0, 1, 2, 3, 4, 5, 6, 7); } } \
        else { _Pragma("unroll") for (int m = 0; m < 4; ++m) _Pragma("unroll") for (int k = 0; k < 2; ++k) dst[m][k] = *(const LAS bf16x8*)(lds + GP_SA(b, h) + aoff + m * 2048 + k * 1024); } } while (0)
#define GP_LDB(dst, b, h) do { if constexpr (F8) { _Pragma("unroll") for (int n = 0; n < 2; ++n) { const v4i32 lo_ = *(const LAS v4i32*)(lds + GP_SB(b, h) + boff + n * 2048), hi_ = *(const LAS v4i32*)(lds + GP_SB(b, h) + boff + n * 2048 + 1024); \
            dst##8[n] = __builtin_shufflevector(lo_, hi_, 0, 1, 2, 3, 4, 5, 6, 7); } } \
        else { _Pragma("unroll") for (int n = 0; n < 2; ++n) _Pragma("unroll") for (int k = 0; k < 2; ++k) dst[n][k] = *(const LAS bf16x8*)(lds + GP_SB(b, h) + boff + n * 2048 + k * 1024); } } while (0)
#define GP_MMA(ai, bj, At, Bt) do { __builtin_amdgcn_s_setprio(1); \
        if constexpr (F8) { _Pragma("unroll") for (int m = 0; m < 4; ++m) _Pragma("unroll") for (int n = 0; n < 2; ++n) \
            acc[ai][bj][m][n] = __builtin_amdgcn_mfma_scale_f32_16x16x128_f8f6f4(Bt##8[n], At##8[m], acc[ai][bj][m][n], 0, 0, 0, 0x7f7f7f7f, 0, 0x7f7f7f7f); } \
        else { _Pragma("unroll") for (int m = 0; m < 4; ++m) _Pragma("unroll") for (int n = 0; n < 2; ++n) _Pragma("unroll") for (int k = 0; k < 2; ++k) \
            acc[ai][bj][m][n] = __builtin_amdgcn_mfma_f32_16x16x32_bf16(Bt[n][k], At[m][k], acc[ai][bj][m][n], 0, 0, 0); } \
        __builtin_amdgcn_s_setprio(0); } while (0)
#define GP_WAIT_V(n) asm volatile("s_waitcnt vmcnt(" #n ")" ::: "memory")
#define GP_WAIT_L(n) asm volatile("s_waitcnt lgkmcnt(" #n ")" ::: "memory")
#define GP_BAR __builtin_amdgcn_s_barrier()
#define GP_SCHED __builtin_amdgcn_sched_barrier(0)
#define GP_BPTR(u, h, t) (((h) ? (u).b1 : (u).b0) + (unsigned)(t) * kstep + (unsigned)(((t) >= (u).ks) ? (u).bd : 0))
    Unit cur, nxt; int ui = 0;
    if (!S.next(0, cur)) return;
    f32x4 acc[2][2][4][2];
#pragma unroll
    for (int a = 0; a < 2; ++a)
#pragma unroll
        for (int b = 0; b < 2; ++b)
#pragma unroll
            for (int m = 0; m < 4; ++m)
#pragma unroll
                for (int n = 0; n < 2; ++n) acc[a][b][m][n] = (f32x4){0.f, 0.f, 0.f, 0.f};
    bf16x8 At[4][2], B0[2][2], B1[2][2]; v8i32 At8[4], B08[2], B18[2];
    unsigned co[2][2];
    unsigned cAu[2];
    if constexpr (GATHER) S.a_rows(cur, tid, co); else { cAu[0] = S.a_half(cur, 0); cAu[1] = S.a_half(cur, 1); }
    GP_STAGE_B(GP_SB(0, 0), GP_BPTR(cur, 0, 0)); GP_STAGE_B(GP_SB(0, 1), GP_BPTR(cur, 1, 0)); GP_STAGE_A(GP_SA(0, 0), 0, 0u); GP_STAGE_A(GP_SA(0, 1), 1, 0u);
    if (wr == 1) GP_BAR;
    GP_WAIT_V(2); GP_BAR;
    GP_STAGE_B(GP_SB(1, 0), GP_BPTR(cur, 0, 1)); GP_STAGE_A(GP_SA(1, 0), 0, kstep); GP_STAGE_B(GP_SB(1, 1), GP_BPTR(cur, 1, 1));
    GP_WAIT_V(6); GP_BAR;
    for (;;) {
        const bool has_next = S.next(ui + 1, nxt);
        if (!has_next) nxt = cur;
        if constexpr (GATHER) { if (has_next) S.rows_prefetch(nxt, rsrc, lds, ui & 1, wid, olane()); }
#pragma nounroll
        for (int t = 0; t < NT; t += 2) {
            const bool last = (t == NT - 2);
            unsigned b2_0, b2_1, b3_0, b3_1, k2;
            if (last) { k2 = 0; b2_0 = GP_BPTR(nxt, 0, 0); b2_1 = GP_BPTR(nxt, 1, 0); b3_0 = GP_BPTR(nxt, 0, 1); b3_1 = GP_BPTR(nxt, 1, 1); }
            else { k2 = (unsigned)(t + 2) * kstep; b2_0 = GP_BPTR(cur, 0, t + 2); b2_1 = GP_BPTR(cur, 1, t + 2); b3_0 = GP_BPTR(cur, 0, t + 3); b3_1 = GP_BPTR(cur, 1, t + 3); }
            GP_LDB(B0, 0, 0); GP_LDB(B1, 0, 1); GP_SCHED; GP_LDA(At, 0, 0); GP_STAGE_A(GP_SA(1, 1), 1, (unsigned)(t + 1) * kstep);
            GP_WAIT_V(8); GP_WAIT_L(0); GP_BAR; GP_MMA(0, 0, At, B0); GP_MMA(0, 1, At, B1); GP_BAR; GP_SCHED;
            if (last && has_next) { if constexpr (GATHER) S.rows_from_lds(nxt, lds, ui & 1, wid * 64 + olane(), co); else { cAu[0] = S.a_half(nxt, 0); cAu[1] = S.a_half(nxt, 1); } }
            GP_LDA(At, 0, 1); GP_STAGE_B(GP_SB(0, 0), b2_0); GP_STAGE_B(GP_SB(0, 1), b2_1); GP_STAGE_A(GP_SA(0, 0), 0, k2);
            GP_WAIT_V(8); GP_WAIT_L(0); GP_BAR; GP_MMA(1, 0, At, B0); GP_MMA(1, 1, At, B1); GP_BAR; GP_SCHED;
            GP_LDB(B0, 1, 0); GP_LDB(B1, 1, 1); GP_SCHED; GP_LDA(At, 1, 0); GP_STAGE_A(GP_SA(0, 1), 1, k2);
            GP_WAIT_V(8); GP_WAIT_L(0); GP_BAR; GP_MMA(0, 0, At, B0); GP_MMA(0, 1, At, B1); GP_BAR; GP_SCHED;
            GP_LDA(At, 1, 1); GP_STAGE_B(GP_SB(1, 0), b3_0); GP_STAGE_B(GP_SB(1, 1), b3_1); GP_STAGE_A(GP_SA(1, 0), 0, k2 + kstep);
            GP_WAIT_V(8); GP_WAIT_L(0); GP_BAR; GP_MMA(1, 0, At, B0); GP_MMA(1, 1, At, B1); GP_BAR; GP_SCHED;
        }
        if constexpr (ALIGN_EPI) { if (wr == 0) GP_BAR; }
        { const int l2 = olane(); E(acc, cur, wr, wc, l2 & 15, l2 >> 4); }
        if (!has_next) break;
#pragma unroll
        for (int a = 0; a < 2; ++a)
#pragma unroll
            for (int b = 0; b < 2; ++b)
#pragma unroll
                for (int m = 0; m < 4; ++m)
#pragma unroll
                    for (int n = 0; n < 2; ++n) acc[a][b][m][n] = (f32x4){0.f, 0.f, 0.f, 0.f};
        cur = nxt; ++ui;
        if constexpr (ALIGN_EPI) { if (wr == 1) GP_BAR; }
    }
    GP_WAIT_V(0);
    if constexpr (!ALIGN_EPI) { if (wr == 0) GP_BAR; }
    GP_BAR;
#undef GP_SA
#undef GP_SB
#undef GP_STAGE_A
#undef GP_STAGE_B
#undef GP_LDA
#undef GP_LDB
#undef GP_MMA
#undef GP_WAIT_V
#undef GP_WAIT_L
#undef GP_BAR
#undef GP_SCHED
#undef GP_BPTR
}
}


typedef f32x4 acc_t[2][2][4][2];
struct SchedRect {
    static constexpr bool GATHER = false;
    int G, c, nM, nN, lda, ldb; unsigned Bt;
    __device__ __forceinline__ bool next(int i, gp::Unit& u) const {
        int pm, pn; if (!gp::static_order(i, G, c, nM, nN, pm, pn)) return false;
        u.pm = pm; u.pn = pn; u.b0 = Bt + (unsigned)(pn * 256 * ldb * 2); u.b1 = u.b0 + (unsigned)(128 * ldb * 2); u.bd = 0; u.ks = 1 << 30; u.x0 = 0; u.x1 = 0; return true; }
    __device__ __forceinline__ int a_pitch() const { return lda * 2; }
    __device__ __forceinline__ unsigned a_half(const gp::Unit& u, int h) const { return (unsigned)((u.pm * 256 + h * 128) * lda * 2); }
};
constexpr int TAB_OFF = 131072;
struct MoeTab {
    LAS const int* tab; int total;
    __device__ __forceinline__ void locate(int tg, int& cls, int& x0, int& nvalid) const {
        cls = __builtin_amdgcn_readfirstlane(tab[4 + 4 * tg]); x0 = __builtin_amdgcn_readfirstlane(tab[5 + 4 * tg]); nvalid = __builtin_amdgcn_readfirstlane(tab[6 + 4 * tg]); }
};
__device__ __forceinline__ MoeTab moe_tab_build(LAS unsigned char* lds, const unsigned* cnt) {
    LAS int* tab = (LAS int*)(lds + TAB_OFF);
    const int tg = threadIdx.x;
    if (tg < 192) {
        int base = 0, cls = 0, x0 = 0, nv = 0;
#pragma nounroll
        for (int c = 0; c < NCLS; ++c) { const int n = (int)cnt[64 * c]; const int nt = (n + 255) >> 8;
            if (tg >= base && tg < base + nt) { cls = c; const int tin = tg - base; x0 = c * R + tin * 256; nv = n - tin * 256 < 256 ? n - tin * 256 : 256; }
            base += nt; }
        tab[4 + 4 * tg] = cls; tab[5 + 4 * tg] = x0; tab[6 + 4 * tg] = nv;
        if (tg == 0) tab[0] = base;
    }
    __syncthreads();
    MoeTab t; t.tab = tab; t.total = __builtin_amdgcn_readfirstlane(tab[0]);
    return t;
}
template <bool F8> struct SchedM1 {
    static constexpr bool GATHER = true;
    int G, c, layer; MoeTab tab; const int* lst; unsigned char* ws;
    static constexpr int EB = F8 ? 1 : 2;
    __device__ __forceinline__ bool next(int i, gp::Unit& u) const {
        int pm, pn; if (!gp::static_order(i, G, c, tab.total, 8, pm, pn)) return false;
        int cls, x0, nv; tab.locate(pm, cls, x0, nv); int elo, ehi; cls_experts(cls, elo, ehi); const int e = pn < 4 ? elo : ehi, pp = pn & 3;
        u.pm = pm; u.pn = pn; u.x0 = x0; u.x1 = nv; u.bd = 0; u.ks = 1 << 30;
        u.b0 = (unsigned)(WS_WEXP + ((size_t)((layer * 16 + e) * 3 + 0)) * MiB) + (unsigned)(pp * 128 * D * EB);
        u.b1 = (unsigned)(WS_WEXP + ((size_t)((layer * 16 + e) * 3 + 1)) * MiB) + (unsigned)(pp * 128 * D * EB); return true; }
    __device__ __forceinline__ void a_rows(const gp::Unit& u, int tid, unsigned (&off)[2][2]) const {
        int Rs[2], Cs[2]; gp::stage_rc(tid * 16, Rs[0], Cs[0]); gp::stage_rc(tid * 16 + 8192, Rs[1], Cs[1]);
#pragma unroll
        for (int h = 0; h < 2; ++h)
#pragma unroll
            for (int i = 0; i < 2; ++i) { const int ri = h * 128 + Rs[i]; int id = lst[u.x0 + (ri < u.x1 ? ri : 0)]; if (ri >= u.x1) id = ZROW; off[h][i] = (unsigned)(id * D * EB + Cs[i] * 2); } }
    static constexpr int ROWC_OFF = 135168;
    __device__ __forceinline__ void rows_prefetch(const gp::Unit& u, __amdgpu_buffer_rsrc_t rs, LAS unsigned char* lds, int par, int wid, int lane) const {
        if (wid == 0) gp::bdma16(rs, (unsigned)lane * 16u, (unsigned)(WS_MISC + MISC_LIST) + (unsigned)u.x0 * 4u, lds + ROWC_OFF + par * 1024); }
    __device__ __forceinline__ void rows_from_lds(const gp::Unit& u, LAS unsigned char* lds, int par, int tid, unsigned (&off)[2][2]) const {
        int Rs[2], Cs[2]; gp::stage_rc(tid * 16, Rs[0], Cs[0]); gp::stage_rc(tid * 16 + 8192, Rs[1], Cs[1]);
        const LAS int* rc = (const LAS int*)(lds + ROWC_OFF + par * 1024);
#pragma unroll
        for (int h = 0; h < 2; ++h)
#pragma unroll
            for (int i = 0; i < 2; ++i) { const int ri = h * 128 + Rs[i]; int id = rc[ri]; if (ri >= u.x1) id = ZROW; off[h][i] = (unsigned)(id * D * EB + Cs[i] * 2); } }
};
template <bool F8> struct SchedM2 {
    static constexpr bool GATHER = false;
    int G, c, layer; MoeTab tab; unsigned char* ws;
    static constexpr int EB = F8 ? 1 : 2;
    __device__ __forceinline__ bool next(int i, gp::Unit& u) const {
        int pm, pn; if (!gp::static_order(i, G, c, tab.total, 4, pm, pn)) return false;
        int cls, x0, nv; tab.locate(pm, cls, x0, nv); int elo, ehi; cls_experts(cls, elo, ehi);
        u.pm = pm; u.pn = pn; u.x0 = x0; u.x1 = nv; u.ks = F8 ? 4 : 8;
        const unsigned wlo = (unsigned)(WS_WEXP + ((size_t)((layer * 16 + elo) * 3 + 2)) * MiB), whi = (unsigned)(WS_WEXP + ((size_t)((layer * 16 + ehi) * 3 + 2)) * MiB);
        u.b0 = wlo + (unsigned)(pn * 256 * DE * EB); u.b1 = u.b0 + (unsigned)(128 * DE * EB); u.bd = (int)(whi - wlo) - (F8 ? 4 : 8) * 128; return true; }
    __device__ __forceinline__ int a_pitch() const { return D * EB; }
    __device__ __forceinline__ unsigned a_half(const gp::Unit& u, int h) const { return (unsigned)((u.pm * 256 + h * 128) * D * EB); }
};
#ifndef EPI_STORE_MODE
#define EPI_STORE_MODE 0
#endif
__device__ __forceinline__ void st16(void* p, u32x4 v) {
    if (EPI_STORE_MODE == 1) asm volatile("global_store_dwordx4 %0, %1, off sc1\n\ts_nop 1" :: "v"(p), "v"(v) : "memory");
    else *(u32x4*)p = v; }
__device__ __forceinline__ void st8(void* p, u32x2 v) {
    if (EPI_STORE_MODE == 1) asm volatile("global_store_dwordx2 %0, %1, off sc1\n\ts_nop 1" :: "v"(p), "v"(v) : "memory");
    else *(u32x2*)p = v; }
__device__ __forceinline__ u32x4 pack8(f32x4 a, f32x4 b) { return (u32x4){pk2(a[0], a[1]), pk2(a[2], a[3]), pk2(b[0], b[1]), pk2(b[2], b[3])}; }
struct EpiP1 {
    static constexpr bool PERM = true;
    bf16_t* Bb; bf16_t* Zb; const float* rs;
    __device__ __forceinline__ void operator()(const acc_t& acc, const gp::Unit& u, int wr, int wc, int fr, int fq) const {
        const int row0 = u.pm * 256 + wr * 64 + fr;
        if (u.pn < 4) { const int col0 = u.pn * 256 + wc * 32 + 8 * fq;
#pragma unroll
            for (int ai = 0; ai < 2; ++ai)
#pragma unroll
                for (int m = 0; m < 4; ++m) { const int row = row0 + ai * 128 + m * 16; const float s = rs[row];
#pragma unroll
                    for (int bj = 0; bj < 2; ++bj) st16(Bb + (size_t)row * D + col0 + bj * 128, pack8(acc[ai][bj][m][0] * s, acc[ai][bj][m][1] * s)); }
        } else { const int col0 = (u.pn - 4) * 128 + wc * 32 + 8 * fq;
#pragma unroll
            for (int ai = 0; ai < 2; ++ai)
#pragma unroll
                for (int m = 0; m < 4; ++m) { const int row = row0 + ai * 128 + m * 16; const float s = rs[row];
                    st16(Zb + (size_t)row * D + col0, pack8((acc[ai][0][m][0] * s) * (acc[ai][1][m][0] * s), (acc[ai][0][m][1] * s) * (acc[ai][1][m][1] * s))); }
        }
    }
};
struct EpiKVQ {
    static constexpr bool PERM = true;
    unsigned char* ws; const float* rs;
    __device__ __forceinline__ void operator()(const acc_t& acc, const gp::Unit& u, int wr, int wc, int fr, int fq) const {
        bf16_t* O = (bf16_t*)(ws + WS_X + (size_t)(u.pn >> 2) * ROWBUF); const float sc = u.pn >= 8 ? QSCALE : 1.f;
        const int row0 = u.pm * 256 + wr * 64 + fr, col0 = (u.pn & 3) * 256 + wc * 32 + 8 * fq;
#pragma unroll
        for (int ai = 0; ai < 2; ++ai)
#pragma unroll
            for (int m = 0; m < 4; ++m) { const int row = row0 + ai * 128 + m * 16; const f32x4* sp = (const f32x4*)(rs + (size_t)row * 16); const f32x4 s0 = sp[0], s1 = sp[1], s2 = sp[2], s3 = sp[3];
                const float ssum = (((s0.x + s0.y) + (s0.z + s0.w)) + ((s1.x + s1.y) + (s1.z + s1.w))) + (((s2.x + s2.y) + (s2.z + s2.w)) + ((s3.x + s3.y) + (s3.z + s3.w))); const float s = sc / sqrtf(ssum * (1.f / D) + RMS_EPS);
#pragma unroll
                for (int bj = 0; bj < 2; ++bj) st16(O + (size_t)row * D + col0 + bj * 128, pack8(acc[ai][bj][m][0] * s, acc[ai][bj][m][1] * s)); }
    }
};
template <bool F8, bool F8OUT> struct EpiM1 {
    static constexpr bool PERM = true;
    bf16_t* H; const float* rs; const float* tw; const int* lst;
    __device__ __forceinline__ void operator()(const acc_t& acc, const gp::Unit& u, int wr, int wc, int fr, int fq) const {
        const int col0 = u.pn * 128 + wc * 32 + 8 * fq, which = u.pn >= 4 ? 1 : 0;
        int rid[2][4]; float s[2][4], w[2][4];
#pragma unroll
        for (int ai = 0; ai < 2; ++ai)
#pragma unroll
            for (int m = 0; m < 4; ++m) { const int rl = ai * 128 + wr * 64 + m * 16 + fr; const int id = lst[u.x0 + (rl < u.x1 ? rl : 0)]; rid[ai][m] = rl < u.x1 ? id : -1; }
#pragma unroll
        for (int ai = 0; ai < 2; ++ai)
#pragma unroll
            for (int m = 0; m < 4; ++m) { const bool valid = rid[ai][m] >= 0; const int rsafe = valid ? rid[ai][m] : 0; const float sv = rs[rsafe], wv = tw[2 * rsafe + which];
                s[ai][m] = valid ? sv * (F8 ? 1.f / (SA8 * SW8) : 1.f) : 0.f; w[ai][m] = valid ? wv * (F8OUT ? SH8 : 1.f) : 0.f; }
#pragma unroll
        for (int ai = 0; ai < 2; ++ai)
#pragma unroll
            for (int m = 0; m < 4; ++m) { const int rl = ai * 128 + wr * 64 + m * 16 + fr; const float sv = s[ai][m], wv = w[ai][m];
                f32x4 o[2];
#pragma unroll
                for (int n = 0; n < 2; ++n)
#pragma unroll
                    for (int q = 0; q < 4; ++q) { const float g = acc[ai][0][m][n][q] * sv, uu = acc[ai][1][m][n][q] * sv; o[n][q] = silu(g) * uu * wv; }
                if constexpr (F8OUT) st8((unsigned char*)H + (size_t)(u.pm * 256 + rl) * D + col0, (u32x2){pk4_fp8(o[0][0], o[0][1], o[0][2], o[0][3]), pk4_fp8(o[1][0], o[1][1], o[1][2], o[1][3])});
                else st16(H + (size_t)(u.pm * 256 + rl) * D + col0, pack8(o[0], o[1])); }
    }
};
template <int MODE> struct EpiRes {
    static constexpr bool PERM = true;
    bf16_t* hb; const int* lst; bool dry; float* ssq; unsigned char* h8; float ascale;
    __device__ __forceinline__ void operator()(const acc_t& acc, const gp::Unit& u, int wr, int wc, int fr, int fq) const {
        if (dry) return;
        const int col0 = u.pn * 256 + wc * 32 + 8 * fq;
        int row[2][4];
#pragma unroll
        for (int ai = 0; ai < 2; ++ai)
#pragma unroll
            for (int m = 0; m < 4; ++m) { const int rl = ai * 128 + wr * 64 + m * 16 + fr;
                if (MODE == 2) { const int id = lst[u.x0 + (rl < u.x1 ? rl : 0)]; row[ai][m] = rl < u.x1 ? id : -1; } else row[ai][m] = u.pm * 256 + rl; }
#pragma unroll
        for (int ai = 0; ai < 2; ++ai) {
            u32x4 old[4][2];
#pragma unroll
            for (int m = 0; m < 4; ++m)
#pragma unroll
                for (int bj = 0; bj < 2; ++bj) old[m][bj] = *(const u32x4*)(hb + (size_t)(row[ai][m] >= 0 ? row[ai][m] : 0) * D + col0 + bj * 128);
#pragma unroll
            for (int m = 0; m < 4; ++m) { float sq = 0.f;
#pragma unroll
                for (int bj = 0; bj < 2; ++bj) { const u32x4 o = old[m][bj];
                    const f32x4 r0 = (f32x4){bflo(o.x), bfhi(o.x), bflo(o.y), bfhi(o.y)} + acc[ai][bj][m][0] * ascale, r1 = (f32x4){bflo(o.z), bfhi(o.z), bflo(o.w), bfhi(o.w)} + acc[ai][bj][m][1] * ascale;
                    const u32x4 p = pack8(r0, r1);
                    if (row[ai][m] >= 0) { st16(hb + (size_t)row[ai][m] * D + col0 + bj * 128, p);
                        if (h8) st8(h8 + (size_t)row[ai][m] * D + col0 + bj * 128, (u32x2){pk4_fp8(r0[0] * SA8, r0[1] * SA8, r0[2] * SA8, r0[3] * SA8), pk4_fp8(r1[0] * SA8, r1[1] * SA8, r1[2] * SA8, r1[3] * SA8)}); }
                    if (ssq) {
#pragma unroll
                        for (int q = 0; q < 4; ++q) { const float x0 = bflo(p[q]), x1 = bfhi(p[q]); sq += x0 * x0 + x1 * x1; } } }
                if (ssq) { sq += __shfl_xor(sq, 16); sq += __shfl_xor(sq, 32); if (fq == 0 && row[ai][m] >= 0) ssq[(size_t)row[ai][m] * 16 + u.pn * 4 + wc] = sq; } }
        }
    }
};

__device__ __forceinline__ void meta_load_a(const bf16_t* A, u32x4 (&a)[32], int lane) {
    const u32x4* ap = (const u32x4*)(A + (size_t)(lane & 15) * D) + (lane >> 4);
#pragma unroll
    for (int s = 0; s < 32; ++s) a[s] = ap[4 * s];
}
__device__ __forceinline__ f32x4 meta_dot(const u32x4 (&a)[32], const bf16_t* Bt, int brow, int lane) {
    const u32x4* bp = (const u32x4*)(Bt + (size_t)brow * D) + (lane >> 4);
    f32x4 acc = (f32x4){0.f, 0.f, 0.f, 0.f};
#pragma unroll
    for (int h = 0; h < 2; ++h) { u32x4 b[16];
#pragma unroll
        for (int s = 0; s < 16; ++s) b[s] = bp[4 * (16 * h + s)];
#pragma unroll
        for (int s = 0; s < 16; ++s) acc = __builtin_amdgcn_mfma_f32_16x16x32_bf16(__builtin_bit_cast(bf16x8, a[16 * h + s]), __builtin_bit_cast(bf16x8, b[s]), acc, 0, 0, 0); }
    return acc;
}
__device__ __forceinline__ void p1_meta(Frame& F) {
    if (F.gw >= 128) return;
    const bf16_t* W = F.wsb(WS_WIN); bf16_t* Bb = F.wsb(WS_X); bf16_t* Zb = F.wsb(WS_X + ROWBUF); const float* rs = F.rstd(0);
    u32x4 a[32]; meta_load_a(F.wsb(WS_HB) + (size_t)META0 * D, a, F.ln());
    const int l15 = F.ln() & 15, kq = F.ln() >> 4;
    for (int g = F.gw; g < 128; g += F.ngw) {
        if (g < 64) { const int col = g * 16 + l15; const f32x4 acc = meta_dot(a, W, col, F.ln());
#pragma unroll
            for (int r = 0; r < 4; ++r) { const int row = META0 + 4 * kq + r; Bb[(size_t)row * D + col] = f2bf(acc[r] * rs[row]); }
        } else { const int j = (g - 64) * 16 + l15; const int cr = 1024 + (j >> 7) * 256 + (j & 127);
            const f32x4 ac = meta_dot(a, W, cr, F.ln()), au = meta_dot(a, W, cr + 128, F.ln());
#pragma unroll
            for (int r = 0; r < 4; ++r) { const int row = META0 + 4 * kq + r; const float s = rs[row]; Zb[(size_t)row * D + j] = f2bf((ac[r] * s) * (au[r] * s)); } }
    }
}
__device__ __forceinline__ void p3_meta(Frame& F) {
    if (F.gw >= 64) return;
    const bf16_t* W = F.wsb(WS_WOUT); bf16_t* hb = F.wsb(WS_HB);
    u32x4 a[32]; meta_load_a(F.wsb(WS_X + 2 * ROWBUF) + (size_t)META0 * D, a, F.ln());
    const int l15 = F.ln() & 15, kq = F.ln() >> 4;
    for (int g = F.gw; g < 64; g += F.ngw) { const int col = g * 16 + l15; const f32x4 acc = meta_dot(a, W, col, F.ln());
#pragma unroll
        for (int r = 0; r < 4; ++r) { bf16_t* hp = hb + (size_t)(META0 + 4 * kq + r) * D + col; const float hn = bf2f(*hp) + acc[r]; *hp = f2bf(hn);
            if (FP8_M1_MASK & 1) *(F.ws + WS_HB8 + (size_t)(META0 + 4 * kq + r) * D + col) = (unsigned char)(pk4_fp8(hn * SA8, 0.f, 0.f, 0.f) & 0xffu); } }
}
__device__ __forceinline__ void p8_meta(Frame& F, const float* rstd) {
    { const int i = F.gw * 64 + F.ln(); if (i < 2 * 48 * 128) { const int buf = i / (48 * 128), rem = i % (48 * 128); *(u32x4*)(F.wsb(WS_X + (size_t)buf * ROWBUF) + (size_t)(NTOK0 + rem / 128) * D + (rem % 128) * 8) = (u32x4){0u, 0u, 0u, 0u}; } }
    if (F.gw >= 192) return;
    const bf16_t* W = F.wsb(WS_WKVQ);
    u32x4 a[32]; meta_load_a(F.wsb(WS_HB) + (size_t)META0 * D, a, F.ln());
    const int l15 = F.ln() & 15, kq = F.ln() >> 4;
    for (int g = F.gw; g < 192; g += F.ngw) { const int n = g * 16 + l15; const f32x4 acc = meta_dot(a, W, n, F.ln());
        bf16_t* O = F.wsb(WS_X + (size_t)(n >> 10) * ROWBUF); const float sc = n >= 2048 ? QSCALE : 1.f; const int col = n & 1023;
#pragma unroll
        for (int r = 0; r < 4; ++r) { const int row = META0 + 4 * kq + r; const f32x4* sp = (const f32x4*)(rstd + (size_t)row * 16); const f32x4 s0 = sp[0], s1 = sp[1], s2 = sp[2], s3 = sp[3];
            const float ssum = (((s0.x + s0.y) + (s0.z + s0.w)) + ((s1.x + s1.y) + (s1.z + s1.w))) + (((s2.x + s2.y) + (s2.z + s2.w)) + ((s3.x + s3.y) + (s3.z + s3.w)));
            O[(size_t)row * D + col] = f2bf(acc[r] * sc / sqrtf(ssum * (1.f / D) + RMS_EPS)); } }
}

__device__ __forceinline__ void p1_opt(Frame& F) {
    p1_meta(F);
    SchedRect S{(int)gridDim.x, (int)blockIdx.x, MMAIN / 256, 12, D, D, (unsigned)WS_WIN};
    EpiP1 E{F.wsb(WS_X), F.wsb(WS_X + ROWBUF), F.rstd(0)};
    gp::gemm_phase<EpiP1, SchedRect, 16>(F.lds, F.wave, F.ws, (unsigned)WS_HB, D * 2, S, E);
}
__device__ __forceinline__ void p3_opt(Frame& F) {
    p3_meta(F);
    SchedRect S{(int)gridDim.x, (int)blockIdx.x, MMAIN / 256, 4, D, D, (unsigned)WS_WOUT};
    EpiRes<0> E{F.wsb(WS_HB), nullptr, false, nullptr, (FP8_M1_MASK & 1) ? F.ws + WS_HB8 : nullptr, 1.f};
    gp::gemm_phase<EpiRes<0>, SchedRect, 16>(F.lds, F.wave, F.ws, (unsigned)(WS_X + 2 * ROWBUF), D * 2, S, E);
}
template <bool F8IN, bool F8OUT> __device__ __forceinline__ void m1_run(Frame& F, int layer, const float* rstd, const unsigned* cnt) {
    SchedM1<F8IN> S; S.G = (int)gridDim.x; S.c = (int)blockIdx.x; S.layer = layer; S.tab = moe_tab_build(F.lds, cnt); S.lst = F.list(); S.ws = F.ws;
    EpiM1<F8IN, F8OUT> E{F.wsb(WS_H), rstd, F.tokw(), F.list()};
    gp::gemm_phase<EpiM1<F8IN, F8OUT>, SchedM1<F8IN>, F8IN ? 8 : 16, F8IN>(F.lds, F.wave, F.ws, F8IN ? (unsigned)WS_HB8 : (unsigned)WS_HB, F8IN ? D : D * 2, S, E);
}
template <bool F8> __device__ __forceinline__ void m2_run(Frame& F, int layer, const unsigned* cnt, bool dry, float* ssq, unsigned char* h8) {
    SchedM2<F8> S; S.G = (int)gridDim.x; S.c = (int)blockIdx.x; S.layer = layer; S.tab = moe_tab_build(F.lds, cnt); S.ws = F.ws;
    EpiRes<2> E{F.wsb(WS_HB), F.list(), dry, ssq, h8, F8 ? 1.f / (SH8 * SWD8) : 1.f};
    gp::gemm_phase<EpiRes<2>, SchedM2<F8>, F8 ? 8 : 16, F8>(F.lds, F.wave, F.ws, (unsigned)WS_H, F8 ? DE : DE * 2, S, E);
}
__device__ __forceinline__ void p8_opt(Frame& F, const float* rstd) {
    p8_meta(F, rstd);
    SchedRect S{(int)gridDim.x, (int)blockIdx.x, MMAIN / 256, 12, D, D, (unsigned)WS_WKVQ};
    EpiKVQ E{F.ws, rstd};
    gp::gemm_phase<EpiKVQ, SchedRect, 16>(F.lds, F.wave, F.ws, (unsigned)WS_HB, D * 2, S, E);
}
__device__ __forceinline__ void p10_opt(Frame& F, const bf16_t* OA, bool dry = false) {
    SchedRect S{(int)gridDim.x, (int)blockIdx.x, MMAIN / 256, 4, D, D, (unsigned)WS_WO};
    EpiRes<0> E{F.wsb(WS_HB), nullptr, dry, nullptr, (FP8_M1_MASK & 2) ? F.ws + WS_HB8 : nullptr, 1.f};
    gp::gemm_phase<EpiRes<0>, SchedRect, 16>(F.lds, F.wave, F.ws, (unsigned)(WS_X + 2 * ROWBUF), D * 2, S, E);
}

namespace att {
using s16x4 = __attribute__((ext_vector_type(4))) short;
typedef short v4i16_t __attribute__((ext_vector_type(4)));
constexpr int DM = 1024, NW = 8, QBLK = 32, QB = 256, KVBLK = 64;
#define SBAR() __builtin_amdgcn_sched_barrier(0)
__device__ __forceinline__ void cmask(f32x16& p0, f32x16& p1, int jb, int qrel, int hi) {
    const float NEG = -INFINITY; int kb = 64 * jb + 4 * hi;
#pragma unroll
    for (int r = 0; r < 16; ++r) { int kv = kb + (r & 3) + 8 * (r >> 2); if (kv > qrel) p0[r] = NEG; if (kv + 32 > qrel) p1[r] = NEG; }
}
constexpr int NSLOT = 3, SLOTB = 8192;
constexpr int LDS_K = 0, LDS_V = NSLOT * SLOTB, LDS_WS = 2 * NSLOT * SLOTB, LDS_OST = LDS_WS + NW * 64 * 4, LDS_BYTES_ATT = LDS_OST + NW * 4096;
__device__ __forceinline__ void glds16(const void* gsrc, unsigned lds_dst) { unsigned keep;
    asm volatile("s_mov_b32 %0, m0\n\ts_mov_b32 m0, %2\n\ts_nop 0\n\tglobal_load_lds_dwordx4 %1, off\n\ts_mov_b32 m0, %0" : "=&s"(keep) : "v"(gsrc), "s"(lds_dst) : "memory"); }
__device__ __forceinline__ float max3f(float a, float b, float c) { float r; asm("v_max3_f32 %0, %1, %2, %3" : "=v"(r) : "v"(a), "v"(b), "v"(c)); return r; }
__device__ __forceinline__ float max2f(float a, float b) { float r; asm("v_max_f32_e32 %0, %1, %2" : "=v"(r) : "v"(a), "v"(b)); return r; }
__device__ __forceinline__ float fadd_s(float a, float b) { float r; asm("v_add_f32_e32 %0, %1, %2" : "=v"(r) : "v"(a), "v"(b)); return r; }
__device__ __forceinline__ float fsub_s(float a, float b) { float r; asm("v_sub_f32_e32 %0, %1, %2" : "=v"(r) : "v"(a), "v"(b)); return r; }
typedef float f32x2_t __attribute__((ext_vector_type(2))); typedef __bf16 bf16x2_t __attribute__((ext_vector_type(2)));
__device__ __forceinline__ unsigned cvtpk_s(float lo, float hi) { f32x2_t v = {lo, hi}; bf16x2_t b = __builtin_convertvector(v, bf16x2_t); return __builtin_bit_cast(unsigned, b); }
#define WAIT_BAR(N) asm volatile("s_waitcnt vmcnt(" #N ") lgkmcnt(0)\n\ts_barrier" ::: "memory")
__device__ __forceinline__ void qkt(f32x16& p0, f32x16& p1, const char* Kslot, const bf16x8* qr, const f32x16& negm, int r32, int hi) {
    const char* kb = Kslot + hi * 1024 + r32 * 16;
#pragma unroll
    for (int d0 = 0; d0 < 4; ++d0) {
        const bf16x8 b0 = *reinterpret_cast<const bf16x8*>(kb + d0 * 2048);
        const bf16x8 b1 = *reinterpret_cast<const bf16x8*>(kb + d0 * 2048 + 512);
        if (d0 == 0) { p0 = __builtin_amdgcn_mfma_f32_32x32x16_bf16(b0, qr[0], negm, 0, 0, 0); p1 = __builtin_amdgcn_mfma_f32_32x32x16_bf16(b1, qr[0], negm, 0, 0, 0); }
        else { p0 = __builtin_amdgcn_mfma_f32_32x32x16_bf16(b0, qr[d0], p0, 0, 0, 0); p1 = __builtin_amdgcn_mfma_f32_32x32x16_bf16(b1, qr[d0], p1, 0, 0, 0); } }
}
typedef __attribute__((address_space(3))) const char* lds_cptr;
__device__ __forceinline__ void kload8(bf16x8* kf, lds_cptr kp) {
    kf[0] = *(const LAS bf16x8*)(kp);        kf[1] = *(const LAS bf16x8*)(kp + 512);
    kf[2] = *(const LAS bf16x8*)(kp + 2048); kf[3] = *(const LAS bf16x8*)(kp + 2560);
    kf[4] = *(const LAS bf16x8*)(kp + 4096); kf[5] = *(const LAS bf16x8*)(kp + 4608);
    kf[6] = *(const LAS bf16x8*)(kp + 6144); kf[7] = *(const LAS bf16x8*)(kp + 6656);
}
__device__ __forceinline__ void kload2(bf16x8* kf, lds_cptr kp, int j) { kf[2 * j] = *(const LAS bf16x8*)(kp + j * 2048); kf[2 * j + 1] = *(const LAS bf16x8*)(kp + j * 2048 + 512); }
__device__ __forceinline__ s16x4 vtr(lds_cptr p) { return __builtin_bit_cast(s16x4, __builtin_amdgcn_ds_read_tr16_b64_v4i16((LAS v4i16_t*)p)); }
__device__ __forceinline__ float rowmax(const f32x16& p0, const f32x16& p1) {
    float a = max3f(p0[0], p0[1], p1[0]), b = max3f(p0[2], p0[3], p1[1]); a = max3f(a, p1[2], p1[3]);
#pragma unroll
    for (int r = 4; r < 16; r += 4) { a = max3f(a, p0[r], p0[r + 1]); b = max3f(b, p0[r + 2], p0[r + 3]); a = max3f(a, p1[r], p1[r + 1]); b = max3f(b, p1[r + 2], p1[r + 3]); }
    const float m = max2f(a, b);
    auto rr = __builtin_amdgcn_permlane32_swap(__float_as_uint(m), __float_as_uint(m), false, false);
    return max2f(__uint_as_float(rr[0]), __uint_as_float(rr[1]));
}
__device__ __forceinline__ void pv(f32x16* o, int vb, bf16x8 pa0, bf16x8 pa1, bf16x8 pa2, bf16x8 pa3) {
#pragma unroll
    for (int d0 = 0; d0 < 2; ++d0) { s16x4 lo[4], hi[4];
#pragma unroll
        for (int ks = 0; ks < 4; ++ks) {
            asm volatile("ds_read_b64_tr_b16 %0,%1 offset:%c2" : "=&v"(lo[ks]) : "v"(vb), "i"(d0 * 4096 + ks * 1024) : "memory");
            asm volatile("ds_read_b64_tr_b16 %0,%1 offset:%c2" : "=&v"(hi[ks]) : "v"(vb), "i"(d0 * 4096 + ks * 1024 + 512) : "memory"); }
        asm volatile("s_waitcnt lgkmcnt(0)" ::: "memory"); SBAR();
#define PK(k) (bf16x8){lo[k][0], lo[k][1], lo[k][2], lo[k][3], hi[k][0], hi[k][1], hi[k][2], hi[k][3]}
        o[d0] = __builtin_amdgcn_mfma_f32_32x32x16_bf16(pa0, PK(0), o[d0], 0, 0, 0);
        o[d0] = __builtin_amdgcn_mfma_f32_32x32x16_bf16(pa1, PK(1), o[d0], 0, 0, 0);
        o[d0] = __builtin_amdgcn_mfma_f32_32x32x16_bf16(pa2, PK(2), o[d0], 0, 0, 0);
        o[d0] = __builtin_amdgcn_mfma_f32_32x32x16_bf16(pa3, PK(3), o[d0], 0, 0, 0);
#undef PK
    }
}
template <int THRL> __device__ __forceinline__ void attn_unit(int qb, const bf16_t* Qu, const bf16_t* __restrict__ Kmeta, const bf16_t* __restrict__ Kmain, const bf16_t* __restrict__ Vmeta, const bf16_t* __restrict__ Vmain, bf16_t* Ou, char* shm) {
    const int tid = threadIdx.x, lane = tid & 63, r32 = lane & 31, hi = lane >> 5; const int wid = __builtin_amdgcn_readfirstlane(tid >> 6);
    const bf16_t* Qw = Qu + (long)(wid * QBLK) * DM;
    const unsigned lds0 = (unsigned)(uintptr_t)shm;
    float* wsf = (float*)(shm + LDS_WS) + wid * 64;
    const long koff = (long)lane * DM + wid * 8, voff = (long)(16 * (wid & 3) + (lane >> 2)) * DM + (wid >> 2) * 32 + (lane & 3) * 8;
    const bf16_t* ksrc = Kmain + koff - (long)KVBLK * DM;
    const bf16_t* vsrc = Vmain + voff - (long)KVBLK * DM;
    const unsigned kdst = lds0 + LDS_K + wid * 1024, vdst = lds0 + LDS_V + wid * 1024;
#define DMA_K(t, slot) glds16(ksrc + (long)(t) * KVBLK * DM, (unsigned)__builtin_amdgcn_readfirstlane(kdst + (slot)))
#define DMA_V(t, slot) glds16(vsrc + (long)(t) * KVBLK * DM, (unsigned)__builtin_amdgcn_readfirstlane(vdst + (slot)))
    const int vb0 = (int)(lds0 + LDS_V) + ((lane >> 4) & 1) * 32 + (lane & 3) * 8 + (4 * hi + ((lane & 15) >> 2)) * 64;
    const char* Kbase = shm + LDS_K; bf16x8 kf[8];
    const lds_cptr shm3 = (lds_cptr)shm; const lds_cptr kp0 = shm3 + LDS_K + hi * 1024 + r32 * 16; const lds_cptr vp0 = shm3 + LDS_V + ((lane >> 4) & 1) * 32 + (lane & 3) * 8 + (4 * hi + ((lane & 15) >> 2)) * 64;
    const int NT = 4 * qb + 5;
    glds16(Kmeta + koff, (unsigned)__builtin_amdgcn_readfirstlane(kdst)); glds16(Vmeta + voff, (unsigned)__builtin_amdgcn_readfirstlane(vdst)); DMA_K(1, SLOTB);
    bf16x8 qr[4];
#pragma unroll
    for (int d0 = 0; d0 < 4; ++d0) qr[d0] = *reinterpret_cast<const bf16x8*>(&Qw[(long)r32 * DM + d0 * 16 + hi * 8]);
    float mhat = 0.f, l_reg = 0.f; f32x16 o[2]; o[0] = f32x16{}; o[1] = f32x16{}; f32x16 negm = f32x16{}; asm volatile("" : "+v"(negm));
    const int qrel = wid * QBLK + r32;
#define CMASK(P0, P1, t) do { int jb_ = (t) - (NT - 4); if (jb_ >= 0) cmask(P0, P1, jb_, qrel, hi); } while (0)
    bool resc = false;
#define START(P0, P1) do { const float rm = rowmax(P0, P1); resc = false; \
    { const float dl = rm; mhat = fadd_s(mhat, dl); \
      _Pragma("unroll") for (int r = 0; r < 16; ++r) { P0[r] = fsub_s(P0[r], dl); P1[r] = fsub_s(P1[r], dl); } \
      _Pragma("unroll") for (int r = 0; r < 16; ++r) negm[r] = -mhat; asm volatile("" : "+v"(negm)); } \
    _Pragma("unroll") for (int r = 0; r < 16; ++r) P0[r] = __builtin_amdgcn_exp2f(P0[r]); } while (0)
#define RESC() do { if (resc) { asm volatile("s_waitcnt lgkmcnt(0)" ::: "memory"); \
      _Pragma("unroll") for (int d_ = 0; d_ < 2; ++d_) _Pragma("unroll") for (int r = 0; r < 16; ++r) o[d_][r] *= wsf[crow(r, hi)]; } } while (0)
    f32x16 pA0, pA1, pB0, pB1;
    int sl_prev = 0, sl_cur = 0, sl_next = SLOTB;
#define ROT() do { sl_prev = sl_cur; sl_cur = sl_next; sl_next = (sl_next == (NSLOT - 1) * SLOTB) ? 0 : sl_next + SLOTB; } while (0)
    DMA_K(2, 2 * SLOTB);
    WAIT_BAR(3);
    qkt(pA0, pA1, Kbase, qr, negm, r32, hi); asm volatile("s_nop 15\n\ts_nop 7" : "+v"(pA0), "+v"(pA1));
#pragma unroll
    for (int r = 8; r < 16; ++r) pA0[r] = -INFINITY;
#pragma unroll
    for (int r = 0; r < 16; ++r) pA1[r] = -INFINITY;
    START(pA0, pA1);
    _Pragma("unroll") for (int r = 0; r < 16; ++r) pA1[r] = __builtin_amdgcn_exp2f(pA1[r]);
    WAIT_BAR(0);
    DMA_K(3, 0); DMA_V(1, SLOTB);
    ROT();
    kload8(kf, kp0 + sl_cur);
    WAIT_BAR(2);
    s16x4 vlo[8], vhi[8]; u32x4 pw0, pw1, pw2, pw3;
#define PKW(P, B) cvtpk_s(P[B], P[B + 1])
#define PAF(k) __builtin_bit_cast(bf16x8, pw##k)
#define VFR(i) (bf16x8){vlo[i][0], vlo[i][1], vlo[i][2], vlo[i][3], vhi[i][0], vhi[i][1], vhi[i][2], vhi[i][3]}
#define PIN(x) asm volatile("" : "+v"(x))
#define MX3(a, b, c) __builtin_fmaxf(__builtin_fmaxf((a), (b)), (c))
#define GAPA(MF, A0, A1, A2, A3, W0, W1, PW) do { MF; sacc += A0; sacc += A1; sacc += A2; sacc += A3; PIN(sacc); W0; W1; PIN(PW); SBAR(); } while (0)
#define EX(v) __builtin_amdgcn_exp2f(v)
#define GAPB(MF, X, B) do { MF; X[B] = EX(X[B]); X[B + 1] = EX(X[B + 1]); X[B + 2] = EX(X[B + 2]); X[B + 3] = EX(X[B + 3]); PIN(X); SBAR(); } while (0)
#define VRD(i) do { vlo[i] = vtr(vp_ + (((i) >> 2) * 4096 + ((i) & 3) * 1024)); vhi[i] = vtr(vp_ + (((i) >> 2) * 4096 + ((i) & 3) * 1024 + 512)); } while (0)
#define KRD(G, j) do { if (G) { kload2(kf, kp0 + sl_next, j); SBAR(); } } while (0)
#define STEP(C0, C1, P0, P1, t, GK, GV, GL) do { SBAR(); \
    const lds_cptr vp_ = vp0 + sl_prev; \
    VRD(0); SBAR(); float sacc = (P0[0] + P0[1]); \
    GAPA(C0 = __builtin_amdgcn_mfma_f32_32x32x16_bf16(kf[0], qr[0], negm, 0, 0, 0), P0[2], P0[3], P0[4], P0[5],     pw0[0] = PKW(P0, 0), pw0[1] = PKW(P0, 2), pw0); \
    VRD(4); SBAR(); GAPA(C1 = __builtin_amdgcn_mfma_f32_32x32x16_bf16(kf[1], qr[0], negm, 0, 0, 0), P0[6], P0[7], P0[8], P0[9],     pw0[2] = PKW(P0, 4), pw0[3] = PKW(P0, 6), pw0); \
    VRD(1); SBAR(); GAPA(C0 = __builtin_amdgcn_mfma_f32_32x32x16_bf16(kf[2], qr[1], C0, 0, 0, 0),   P0[10], P0[11], P0[12], P0[13], pw1[0] = PKW(P0, 8), pw1[1] = PKW(P0, 10), pw1); \
    VRD(5); SBAR(); GAPA(C1 = __builtin_amdgcn_mfma_f32_32x32x16_bf16(kf[3], qr[1], C1, 0, 0, 0),   P0[14], P0[15], P1[0], P1[1],   pw1[2] = PKW(P0, 12), pw1[3] = PKW(P0, 14), pw1); \
    VRD(2); SBAR(); GAPA(C0 = __builtin_amdgcn_mfma_f32_32x32x16_bf16(kf[4], qr[2], C0, 0, 0, 0),   P1[2], P1[3], P1[4], P1[5],     pw2[0] = PKW(P1, 0), pw2[1] = PKW(P1, 2), pw2); \
    VRD(6); SBAR(); GAPA(C1 = __builtin_amdgcn_mfma_f32_32x32x16_bf16(kf[5], qr[2], C1, 0, 0, 0),   P1[6], P1[7], P1[8], P1[9],     pw2[2] = PKW(P1, 4), pw2[3] = PKW(P1, 6), pw2); \
    VRD(3); SBAR(); GAPA(C0 = __builtin_amdgcn_mfma_f32_32x32x16_bf16(kf[6], qr[3], C0, 0, 0, 0),   P1[10], P1[11], P1[12], P1[13], pw3[0] = PKW(P1, 8), pw3[1] = PKW(P1, 10), pw3); \
    VRD(7); SBAR(); GAPA(C1 = __builtin_amdgcn_mfma_f32_32x32x16_bf16(kf[7], qr[3], C1, 0, 0, 0),   P1[14], P1[15], 0.f, 0.f,       pw3[2] = PKW(P1, 12), pw3[3] = PKW(P1, 14), pw3); \
    l_reg += sacc; \
    if (GK) { DMA_K((t) + 3, sl_cur); } if (GV) { DMA_V((t) + 1, sl_next); } \
    CMASK(C0, C1, t); \
    { float a = MX3(C0[0], C0[1], C1[0]), b = MX3(C0[2], C0[3], C1[1]); a = MX3(a, C1[2], C1[3]); \
      _Pragma("unroll") for (int r = 4; r < 16; r += 4) { a = MX3(a, C0[r], C0[r + 1]); b = MX3(b, C0[r + 2], C0[r + 3]); a = MX3(a, C1[r], C1[r + 1]); b = MX3(b, C1[r + 2], C1[r + 3]); } \
      float rm = __builtin_fmaxf(a, b); { auto rr = __builtin_amdgcn_permlane32_swap(__float_as_uint(rm), __float_as_uint(rm), false, false); rm = __builtin_fmaxf(__uint_as_float(rr[0]), __uint_as_float(rr[1])); } \
      resc = false; \
      if (__builtin_expect(__any(rm > (float)THRL), 0)) { const float dl = __builtin_fmaxf(rm, 0.f); mhat += dl; \
        _Pragma("unroll") for (int r = 0; r < 16; ++r) { C0[r] -= dl; C1[r] -= dl; } \
        _Pragma("unroll") for (int r = 0; r < 16; ++r) negm[r] = -mhat; asm volatile("" : "+v"(negm)); \
        const float f = __builtin_amdgcn_exp2f(-dl); l_reg *= f; if (hi == 0) wsf[r32] = f; resc = true; } } \
    SBAR(); \
    GAPB(o[0] = __builtin_amdgcn_mfma_f32_32x32x16_bf16(PAF(0), VFR(0), o[0], 0, 0, 0), C0, 0); \
    GAPB(o[1] = __builtin_amdgcn_mfma_f32_32x32x16_bf16(PAF(0), VFR(4), o[1], 0, 0, 0), C0, 4); \
    KRD(GL, 0); GAPB(o[0] = __builtin_amdgcn_mfma_f32_32x32x16_bf16(PAF(1), VFR(1), o[0], 0, 0, 0), C0, 8); \
    KRD(GL, 1); GAPB(o[1] = __builtin_amdgcn_mfma_f32_32x32x16_bf16(PAF(1), VFR(5), o[1], 0, 0, 0), C0, 12); \
    KRD(GL, 2); GAPB(o[0] = __builtin_amdgcn_mfma_f32_32x32x16_bf16(PAF(2), VFR(2), o[0], 0, 0, 0), C1, 0); \
    KRD(GL, 3); GAPB(o[1] = __builtin_amdgcn_mfma_f32_32x32x16_bf16(PAF(2), VFR(6), o[1], 0, 0, 0), C1, 4); \
    GAPB(o[0] = __builtin_amdgcn_mfma_f32_32x32x16_bf16(PAF(3), VFR(3), o[0], 0, 0, 0), C1, 8); \
    GAPB(o[1] = __builtin_amdgcn_mfma_f32_32x32x16_bf16(PAF(3), VFR(7), o[1], 0, 0, 0), C1, 12); \
    } while (0)
    int t = 1;
#undef CMASK
#define CMASK(P0, P1, t) do { } while (0)
    for (; t + 5 < NT; t += 2) {
        STEP(pB0, pB1, pA0, pA1, t, true, true, true);     WAIT_BAR(2); RESC(); ROT();
        STEP(pA0, pA1, pB0, pB1, t + 1, true, true, true); WAIT_BAR(2); RESC(); ROT();
    }
#undef CMASK
#define CMASK(P0, P1, t) do { int jb_ = (t) - (NT - 4); if (jb_ >= 0) cmask(P0, P1, jb_, qrel, hi); } while (0)
#define ENDW(tt) do { if ((tt) + 3 < NT) { WAIT_BAR(2); } else if ((tt) + 2 < NT) { WAIT_BAR(1); } else { WAIT_BAR(0); } } while (0)
    for (; t + 1 < NT; t += 2) {
        STEP(pB0, pB1, pA0, pA1, t, (t + 3 < NT), (t + 1 < NT), (t + 1 < NT));         ENDW(t);     RESC(); ROT();
        STEP(pA0, pA1, pB0, pB1, t + 1, (t + 4 < NT), (t + 2 < NT), (t + 2 < NT));     ENDW(t + 1); RESC(); ROT();
    }
    { float sacc = pA0[0] + pA0[1]; _Pragma("unroll") for (int r = 2; r < 16; ++r) sacc += pA0[r]; _Pragma("unroll") for (int r = 0; r < 16; ++r) sacc += pA1[r]; l_reg += sacc;
      pw0 = (u32x4){PKW(pA0, 0), PKW(pA0, 2), PKW(pA0, 4), PKW(pA0, 6)}; pw1 = (u32x4){PKW(pA0, 8), PKW(pA0, 10), PKW(pA0, 12), PKW(pA0, 14)}; pw2 = (u32x4){PKW(pA1, 0), PKW(pA1, 2), PKW(pA1, 4), PKW(pA1, 6)}; pw3 = (u32x4){PKW(pA1, 8), PKW(pA1, 10), PKW(pA1, 12), PKW(pA1, 14)};
      SBAR(); pv(o, vb0 + sl_prev, PAF(0), PAF(1), PAF(2), PAF(3)); }
#undef PKW
#undef PAF
#undef VFR
#undef PIN
#undef MX3
#undef GAPA
#undef GAPB
#undef EX
#undef VRD
#undef KRD
#undef STEP
#undef ENDW
    { auto rr = __builtin_amdgcn_permlane32_swap(__float_as_uint(l_reg), __float_as_uint(l_reg), false, false); l_reg = __uint_as_float(rr[0]) + __uint_as_float(rr[1]); }
    if (hi == 0) wsf[32 + r32] = l_reg; asm volatile("s_waitcnt lgkmcnt(0)" ::: "memory");
    float rli[16];
#pragma unroll
    for (int r = 0; r < 16; ++r) rli[r] = __builtin_amdgcn_rcpf(wsf[32 + crow(r, hi)]);
    bf16_t* Ow = Ou + (long)(wid * QBLK) * DM;
    { bf16_t* stg = (bf16_t*)(shm + LDS_OST) + wid * 2048;
#pragma unroll
      for (int r = 0; r < 16; ++r) { const int orow = crow(r, hi);
#pragma unroll
          for (int d0 = 0; d0 < 2; ++d0) stg[orow * 64 + d0 * 32 + r32] = f2bf(o[d0][r] * rli[r]); }
      asm volatile("s_waitcnt lgkmcnt(0)" ::: "memory");
#pragma unroll
      for (int i = 0; i < 4; ++i) { const int row = i * 8 + (lane >> 3), ch = lane & 7; const u32x4 v = *(const u32x4*)(stg + row * 64 + ch * 8); *(u32x4*)(Ow + (long)row * DM + ch * 8) = v; } }
    asm volatile("s_waitcnt lgkmcnt(0)\n\ts_barrier" ::: "memory");
#undef DMA_K
#undef DMA_V
#undef CMASK
#undef START
#undef RESC
#undef ROT
}
#undef SBAR
#undef WAIT_BAR
}

namespace att2 {
using s16x4 = __attribute__((ext_vector_type(4))) short;
typedef short v4i16_t __attribute__((ext_vector_type(4)));
constexpr int DM = 1024, NW = 8, QBLK = 32, KVBLK = 64;
#define SBAR() __builtin_amdgcn_sched_barrier(0)
constexpr int KSLOT = 8192, NKS = 4, VSLOT = 16384, NVS = 3;
constexpr int LDS_K = 0, LDS_V = NKS * KSLOT, LDS_WS = LDS_V + NVS * VSLOT, LDS_OST = LDS_WS + NW * 64 * 4, LDS_END = LDS_OST + NW * 8192;
__device__ __forceinline__ void glds16(const void* gsrc, unsigned lds_dst) { unsigned keep;
    asm volatile("s_mov_b32 %0, m0\n\ts_mov_b32 m0, %2\n\ts_nop 0\n\tglobal_load_lds_dwordx4 %1, off\n\ts_mov_b32 m0, %0" : "=&s"(keep) : "v"(gsrc), "s"(lds_dst) : "memory"); }
typedef __attribute__((address_space(3))) const char* lds_cptr;
#define WAIT_BAR(N) asm volatile("s_waitcnt vmcnt(" #N ") lgkmcnt(0)\n\ts_barrier" ::: "memory")
using att::max3f; using att::max2f; using att::fadd_s; using att::fsub_s; using att::cvtpk_s; using att::cmask; using att::rowmax;
__device__ __forceinline__ s16x4 vtr(lds_cptr p) { return __builtin_bit_cast(s16x4, __builtin_amdgcn_ds_read_tr16_b64_v4i16((LAS v4i16_t*)p)); }
__device__ __forceinline__ bf16x8 kfrag(lds_cptr kp, int i) { return *(const LAS bf16x8*)(kp + (i >> 1) * 2048 + (i & 1) * 512); }

template <int THRL> __device__ __forceinline__ void attn_pass(int qb, const bf16_t* Qu, const bf16_t* __restrict__ Kmeta, const bf16_t* __restrict__ Kmain, const bf16_t* __restrict__ Vmeta, const bf16_t* __restrict__ Vmain,
                                                              f32x16 (&o)[4], float& l_out, char* shm) {
    int tid = threadIdx.x; asm volatile("" : "+v"(tid));
    const int lane = tid & 63, r32 = lane & 31, hi = lane >> 5; const int wid = __builtin_amdgcn_readfirstlane(tid >> 6);
    const bf16_t* Qw = Qu + (long)(wid * QBLK) * DM;
    const unsigned lds0 = (unsigned)(uintptr_t)shm;
    float* wsf = (float*)(shm + LDS_WS) + wid * 64;
    const long koff = (long)lane * DM + wid * 8, voff = (long)(16 * (wid & 3) + (lane >> 2)) * DM + (wid >> 2) * 32 + (lane & 3) * 8;
    const bf16_t* ksrc = Kmain + koff - (long)KVBLK * DM;
    const bf16_t* vsrc = Vmain + voff - (long)KVBLK * DM;
    const unsigned kdst = lds0 + LDS_K + wid * 1024, vdst = lds0 + LDS_V + wid * 1024;
#define DMA_K(t, slot) glds16(ksrc + (long)(t) * KVBLK * DM, (unsigned)__builtin_amdgcn_readfirstlane(kdst + (slot)))
#define DMA_V(t, slot) do { glds16(vsrc + (long)(t) * KVBLK * DM, (unsigned)__builtin_amdgcn_readfirstlane(vdst + (slot))); glds16(vsrc + (long)(t) * KVBLK * DM + 64, (unsigned)__builtin_amdgcn_readfirstlane(vdst + (slot) + 8192)); } while (0)
    const lds_cptr shm3 = (lds_cptr)shm; const lds_cptr kp0 = shm3 + LDS_K + hi * 1024 + r32 * 16; const lds_cptr vp0 = shm3 + LDS_V + ((lane >> 4) & 1) * 32 + (lane & 3) * 8 + (4 * hi + ((lane & 15) >> 2)) * 64;
    const int NT = 4 * qb + 5;
    glds16(Kmeta + koff, (unsigned)__builtin_amdgcn_readfirstlane(kdst));
    glds16(Vmeta + voff, (unsigned)__builtin_amdgcn_readfirstlane(vdst)); glds16(Vmeta + voff + 64, (unsigned)__builtin_amdgcn_readfirstlane(vdst + 8192));
    DMA_K(1, KSLOT); DMA_K(2, 2 * KSLOT);
    bf16x8 qr[4];
#pragma unroll
    for (int d0 = 0; d0 < 4; ++d0) qr[d0] = *reinterpret_cast<const bf16x8*>(&Qw[(long)r32 * DM + d0 * 16 + hi * 8]);
    float mhat = 0.f, l_reg = 0.f;
#pragma unroll
    for (int d = 0; d < 4; ++d) o[d] = f32x16{};
    f32x16 negm = f32x16{}; asm volatile("" : "+v"(negm));
    const int qrel = wid * QBLK + r32;
#define CMASK(P0, P1, t) do { int jb_ = (t) - (NT - 4); if (jb_ >= 0) cmask(P0, P1, jb_, qrel, hi); } while (0)
    bool resc = false;
#define RESC() do { if (resc) { asm volatile("s_waitcnt lgkmcnt(0)" ::: "memory"); \
      _Pragma("unroll") for (int d_ = 0; d_ < 4; ++d_) _Pragma("unroll") for (int r = 0; r < 16; ++r) o[d_][r] *= wsf[crow(r, hi)]; } } while (0)
    f32x16 pA0, pA1, pB0, pB1;
    int ks_cur = 0, ks_next = KSLOT, ks_prev = 3 * KSLOT;
    int vs_prev = 0, vs_cur = 0, vs_next = VSLOT;
#define ROT() do { ks_prev = ks_cur; ks_cur = ks_next; ks_next = (ks_next == (NKS - 1) * KSLOT) ? 0 : ks_next + KSLOT; vs_prev = vs_cur; vs_cur = vs_next; vs_next = (vs_next == (NVS - 1) * VSLOT) ? 0 : vs_next + VSLOT; } while (0)
    WAIT_BAR(4);
    { const lds_cptr kp = kp0;
#pragma unroll
      for (int d0 = 0; d0 < 4; ++d0) { const bf16x8 b0 = kfrag(kp, 2 * d0), b1 = kfrag(kp, 2 * d0 + 1);
          if (d0 == 0) { pA0 = __builtin_amdgcn_mfma_f32_32x32x16_bf16(b0, qr[0], negm, 0, 0, 0); pA1 = __builtin_amdgcn_mfma_f32_32x32x16_bf16(b1, qr[0], negm, 0, 0, 0); }
          else { pA0 = __builtin_amdgcn_mfma_f32_32x32x16_bf16(b0, qr[d0], pA0, 0, 0, 0); pA1 = __builtin_amdgcn_mfma_f32_32x32x16_bf16(b1, qr[d0], pA1, 0, 0, 0); } } }
    asm volatile("s_nop 15\n\ts_nop 7" : "+v"(pA0), "+v"(pA1));
#pragma unroll
    for (int r = 8; r < 16; ++r) pA0[r] = -INFINITY;
#pragma unroll
    for (int r = 0; r < 16; ++r) pA1[r] = -INFINITY;
    { const float rm = rowmax(pA0, pA1); mhat = fadd_s(mhat, rm);
#pragma unroll
      for (int r = 0; r < 16; ++r) { pA0[r] = fsub_s(pA0[r], rm); pA1[r] = fsub_s(pA1[r], rm); }
#pragma unroll
      for (int r = 0; r < 16; ++r) negm[r] = -mhat;
      asm volatile("" : "+v"(negm));
#pragma unroll
      for (int r = 0; r < 16; ++r) { pA0[r] = __builtin_amdgcn_exp2f(pA0[r]); pA1[r] = __builtin_amdgcn_exp2f(pA1[r]); } }
    DMA_K(3, 3 * KSLOT); DMA_V(1, VSLOT);
    WAIT_BAR(3);
    ROT();
    bf16x8 kf[8]; s16x4 vlo[16], vhi[16]; u32x4 pw0, pw1, pw2, pw3;
    kf[0] = kfrag(kp0 + ks_cur, 0); kf[1] = kfrag(kp0 + ks_cur, 1);
#define PKW(P, B) cvtpk_s(P[B], P[B + 1])
#define PAF(k) __builtin_bit_cast(bf16x8, pw##k)
#define VFR(i) (bf16x8){vlo[i][0], vlo[i][1], vlo[i][2], vlo[i][3], vhi[i][0], vhi[i][1], vhi[i][2], vhi[i][3]}
#define PIN(x) asm volatile("" : "+v"(x))
#define MX3(a, b, c) __builtin_fmaxf(__builtin_fmaxf((a), (b)), (c))
#define EX(v) __builtin_amdgcn_exp2f(v)
#define VIX(j) ((((j) & 3) << 2) + ((j) >> 2))
#define VRD(i) do { vlo[i] = vtr(vp_ + (((i) >> 2) * 4096 + ((i) & 3) * 1024)); vhi[i] = vtr(vp_ + (((i) >> 2) * 4096 + ((i) & 3) * 1024 + 512)); } while (0)
#define KRD(i) do { kf[i] = kfrag(kpc_, i); } while (0)
#define GAPA(i, MF, A0, A1, A2, A3, W0, W1, PW) do { if ((i) + 2 < 8) KRD(((i) + 2) & 7); SBAR(); MF; sacc += A0; sacc += A1; sacc += A2; sacc += A3; PIN(sacc); W0; W1; PIN(PW); SBAR(); } while (0)
#define GAPB(j, PA, X, B) do { if ((j) + 2 < 16) VRD(VIX(((j) + 2) & 15)); SBAR(); o[(j) & 3] = __builtin_amdgcn_mfma_f32_32x32x16_bf16(PA, VFR(VIX(j)), o[(j) & 3], 0, 0, 0); X[B] = EX(X[B]); X[B + 1] = EX(X[B + 1]); PIN(X); SBAR(); } while (0)
#define STEP(C0, C1, P0, P1, t, GK, GV, GL) do { SBAR(); \
    const lds_cptr kpc_ = kp0 + ks_cur; const lds_cptr vp_ = vp0 + vs_prev; \
    float sacc = (P0[0] + P0[1]); \
    GAPA(0, C0 = __builtin_amdgcn_mfma_f32_32x32x16_bf16(kf[0], qr[0], negm, 0, 0, 0), P0[2], P0[3], P0[4], P0[5],     pw0[0] = PKW(P0, 0), pw0[1] = PKW(P0, 2), pw0); \
    GAPA(1, C1 = __builtin_amdgcn_mfma_f32_32x32x16_bf16(kf[1], qr[0], negm, 0, 0, 0), P0[6], P0[7], P0[8], P0[9],     pw0[2] = PKW(P0, 4), pw0[3] = PKW(P0, 6), pw0); \
    GAPA(2, C0 = __builtin_amdgcn_mfma_f32_32x32x16_bf16(kf[2], qr[1], C0, 0, 0, 0),   P0[10], P0[11], P0[12], P0[13], pw1[0] = PKW(P0, 8), pw1[1] = PKW(P0, 10), pw1); \
    GAPA(3, C1 = __builtin_amdgcn_mfma_f32_32x32x16_bf16(kf[3], qr[1], C1, 0, 0, 0),   P0[14], P0[15], P1[0], P1[1],   pw1[2] = PKW(P0, 12), pw1[3] = PKW(P0, 14), pw1); \
    GAPA(4, C0 = __builtin_amdgcn_mfma_f32_32x32x16_bf16(kf[4], qr[2], C0, 0, 0, 0),   P1[2], P1[3], P1[4], P1[5],     pw2[0] = PKW(P1, 0), pw2[1] = PKW(P1, 2), pw2); \
    GAPA(5, C1 = __builtin_amdgcn_mfma_f32_32x32x16_bf16(kf[5], qr[2], C1, 0, 0, 0),   P1[6], P1[7], P1[8], P1[9],     pw2[2] = PKW(P1, 4), pw2[3] = PKW(P1, 6), pw2); \
    GAPA(6, C0 = __builtin_amdgcn_mfma_f32_32x32x16_bf16(kf[6], qr[3], C0, 0, 0, 0),   P1[10], P1[11], P1[12], P1[13], pw3[0] = PKW(P1, 8), pw3[1] = PKW(P1, 10), pw3); \
    GAPA(7, C1 = __builtin_amdgcn_mfma_f32_32x32x16_bf16(kf[7], qr[3], C1, 0, 0, 0),   P1[14], P1[15], 0.f, 0.f,       pw3[2] = PKW(P1, 12), pw3[3] = PKW(P1, 14), pw3); \
    l_reg += sacc; \
    VRD(VIX(0)); VRD(VIX(1)); SBAR(); \
    if (GK) { DMA_K((t) + 3, ks_prev); } if (GV) { DMA_V((t) + 1, vs_next); } \
    CMASK(C0, C1, t); \
    { float a = MX3(C0[0], C0[1], C1[0]), b = MX3(C0[2], C0[3], C1[1]); a = MX3(a, C1[2], C1[3]); \
      _Pragma("unroll") for (int r = 4; r < 16; r += 4) { a = MX3(a, C0[r], C0[r + 1]); b = MX3(b, C0[r + 2], C0[r + 3]); a = MX3(a, C1[r], C1[r + 1]); b = MX3(b, C1[r + 2], C1[r + 3]); } \
      float rm = __builtin_fmaxf(a, b); { auto rr = __builtin_amdgcn_permlane32_swap(__float_as_uint(rm), __float_as_uint(rm), false, false); rm = __builtin_fmaxf(__uint_as_float(rr[0]), __uint_as_float(rr[1])); } \
      resc = false; \
      if (__builtin_expect(__any(rm > (float)THRL), 0)) { const float dl = __builtin_fmaxf(rm, 0.f); mhat += dl; \
        _Pragma("unroll") for (int r = 0; r < 16; ++r) { C0[r] -= dl; C1[r] -= dl; } \
        _Pragma("unroll") for (int r = 0; r < 16; ++r) negm[r] = -mhat; asm volatile("" : "+v"(negm)); \
        const float f = __builtin_amdgcn_exp2f(-dl); l_reg *= f; if (hi == 0) wsf[r32] = f; resc = true; } } \
    SBAR(); \
    GAPB(0, PAF(0), C0, 0);  GAPB(1, PAF(0), C0, 2);  GAPB(2, PAF(0), C0, 4);  GAPB(3, PAF(0), C0, 6); \
    GAPB(4, PAF(1), C0, 8);  GAPB(5, PAF(1), C0, 10); GAPB(6, PAF(1), C0, 12); GAPB(7, PAF(1), C0, 14); \
    GAPB(8, PAF(2), C1, 0);  GAPB(9, PAF(2), C1, 2);  GAPB(10, PAF(2), C1, 4); GAPB(11, PAF(2), C1, 6); \
    if (GL) { kf[0] = kfrag(kp0 + ks_next, 0); kf[1] = kfrag(kp0 + ks_next, 1); SBAR(); } \
    GAPB(12, PAF(3), C1, 8); GAPB(13, PAF(3), C1, 10); GAPB(14, PAF(3), C1, 12); GAPB(15, PAF(3), C1, 14); \
    } while (0)
    int t = 1;
#undef CMASK
#define CMASK(P0, P1, t) do { } while (0)
    for (; t + 5 < NT; t += 2) {
        STEP(pB0, pB1, pA0, pA1, t, true, true, true);     WAIT_BAR(3); RESC(); ROT();
        STEP(pA0, pA1, pB0, pB1, t + 1, true, true, true); WAIT_BAR(3); RESC(); ROT();
    }
#undef CMASK
#define CMASK(P0, P1, t) do { int jb_ = (t) - (NT - 4); if (jb_ >= 0) cmask(P0, P1, jb_, qrel, hi); } while (0)
#define ENDW(tt) do { if ((tt) + 3 < NT) { WAIT_BAR(3); } else if ((tt) + 1 < NT) { WAIT_BAR(2); } else { WAIT_BAR(0); } } while (0)
    for (; t + 1 < NT; t += 2) {
        STEP(pB0, pB1, pA0, pA1, t, (t + 3 < NT), (t + 1 < NT), (t + 1 < NT));         ENDW(t);     RESC(); ROT();
        STEP(pA0, pA1, pB0, pB1, t + 1, (t + 4 < NT), (t + 2 < NT), (t + 2 < NT));     ENDW(t + 1); RESC(); ROT();
    }
    { float sacc = pA0[0] + pA0[1]; _Pragma("unroll") for (int r = 2; r < 16; ++r) sacc += pA0[r]; _Pragma("unroll") for (int r = 0; r < 16; ++r) sacc += pA1[r]; l_reg += sacc;
      pw0 = (u32x4){PKW(pA0, 0), PKW(pA0, 2), PKW(pA0, 4), PKW(pA0, 6)}; pw1 = (u32x4){PKW(pA0, 8), PKW(pA0, 10), PKW(pA0, 12), PKW(pA0, 14)}; pw2 = (u32x4){PKW(pA1, 0), PKW(pA1, 2), PKW(pA1, 4), PKW(pA1, 6)}; pw3 = (u32x4){PKW(pA1, 8), PKW(pA1, 10), PKW(pA1, 12), PKW(pA1, 14)};
      const lds_cptr vp_ = vp0 + vs_prev;
#pragma unroll
      for (int dq = 0; dq < 4; ++dq) {
          VRD(dq * 4 + 0); VRD(dq * 4 + 1); VRD(dq * 4 + 2); VRD(dq * 4 + 3);
          o[dq] = __builtin_amdgcn_mfma_f32_32x32x16_bf16(PAF(0), VFR(dq * 4 + 0), o[dq], 0, 0, 0);
          o[dq] = __builtin_amdgcn_mfma_f32_32x32x16_bf16(PAF(1), VFR(dq * 4 + 1), o[dq], 0, 0, 0);
          o[dq] = __builtin_amdgcn_mfma_f32_32x32x16_bf16(PAF(2), VFR(dq * 4 + 2), o[dq], 0, 0, 0);
          o[dq] = __builtin_amdgcn_mfma_f32_32x32x16_bf16(PAF(3), VFR(dq * 4 + 3), o[dq], 0, 0, 0); } }
#undef PKW
#undef PAF
#undef VFR
#undef PIN
#undef MX3
#undef EX
#undef VIX
#undef VRD
#undef KRD
#undef GAPA
#undef GAPB
#undef STEP
#undef ENDW
#undef DMA_K
#undef DMA_V
#undef CMASK
#undef RESC
#undef ROT
    { auto rr = __builtin_amdgcn_permlane32_swap(__float_as_uint(l_reg), __float_as_uint(l_reg), false, false); l_reg = __uint_as_float(rr[0]) + __uint_as_float(rr[1]); }
    l_out = l_reg;
    asm volatile("s_waitcnt lgkmcnt(0)\n\ts_barrier" ::: "memory");
}
__device__ __forceinline__ void attn_unit(int qb, int b, int h, const bf16_t* Qb, const bf16_t* Kb, const bf16_t* Vb, bf16_t* OA, float lam, char* shm) {
    int tid = threadIdx.x; asm volatile("" : "+v"(tid));
    const int lane = tid & 63, r32 = lane & 31, hi = lane >> 5; const int wid = __builtin_amdgcn_readfirstlane(tid >> 6);
    float* wsf = (float*)(shm + LDS_WS) + wid * 64;
    bf16_t* stg = (bf16_t*)(shm + LDS_OST) + wid * 4096;
    bf16_t* sl = stg + hi * 512 + r32;
    const float* wl = wsf + 32 + 4 * hi;
#define CR(r) (((r) & 3) + 8 * ((r) >> 2))
    const long row0 = (long)b * SEQ + qb * 256;
    f32x16 o[4]; float l_reg;
#pragma unroll 1
    for (int c = 0; c < 2; ++c) {
        const int hc = 2 * h + c;
        attn_pass<8>(qb, Qb + row0 * D + hc * 64, Kb + (long)META0 * D + hc * 64, Kb + (long)b * SEQ * D + hc * 64, Vb + (long)META0 * D + h * 128, Vb + (long)b * SEQ * D + h * 128, o, l_reg, shm);
        if (hi == 0) wsf[32 + r32] = l_reg; asm volatile("s_waitcnt lgkmcnt(0)" ::: "memory");
        if (c == 0) {
#pragma unroll
            for (int r = 0; r < 16; ++r) { const float rl = __builtin_amdgcn_rcpf(wl[CR(r)]);
#pragma unroll
                for (int d = 0; d < 4; ++d) sl[CR(r) * 128 + d * 32] = f2bf(o[d][r] * rl); }
            asm volatile("s_waitcnt lgkmcnt(0)" ::: "memory");
        } else {
            float ps[16];
#pragma unroll
            for (int r = 0; r < 16; ++r) { const float rl = lam * __builtin_amdgcn_rcpf(wl[CR(r)]); float s = 0.f;
#pragma unroll
                for (int d = 0; d < 4; ++d) { const float v = bf2f(sl[CR(r) * 128 + d * 32]) - o[d][r] * rl; o[d][r] = v; s += v * v; }
                ps[r] = s; }
#pragma unroll
            for (int r = 0; r < 16; ++r) { float s = ps[r]; s += __shfl_xor(s, 1); s += __shfl_xor(s, 2); s += __shfl_xor(s, 4); s += __shfl_xor(s, 8); s += __shfl_xor(s, 16); ps[r] = 1.0f / sqrtf(s * (1.f / 128.f) + SUBLN_EPS); }
            asm volatile("s_waitcnt lgkmcnt(0)" ::: "memory");
#pragma unroll
            for (int r = 0; r < 16; ++r) {
#pragma unroll
                for (int d = 0; d < 4; ++d) sl[CR(r) * 128 + d * 32] = f2bf(o[d][r] * ps[r]); }
            asm volatile("s_waitcnt lgkmcnt(0)" ::: "memory");
            int l2 = lane; asm volatile("" : "+v"(l2));
            bf16_t* Ow = OA + (row0 + wid * QBLK + (l2 >> 4)) * D + h * 128 + (l2 & 15) * 8; const bf16_t* sr = stg + (l2 >> 4) * 128 + (l2 & 15) * 8;
#pragma unroll
            for (int i = 0; i < 8; ++i) { const u32x4 v = *(const u32x4*)(sr + i * 512); *(u32x4*)(Ow + (long)i * 4 * D) = v; }
            asm volatile("s_waitcnt lgkmcnt(0)" ::: "memory");
        }
    }
#undef CR
}
#undef SBAR
#undef WAIT_BAR
}
__device__ __forceinline__ void p9_attn2(Frame& F, bf16_t* OA) {
    const bf16_t* Kb = F.wsb(WS_X); const bf16_t* Vb = F.wsb(WS_X + ROWBUF); const bf16_t* Qb = F.wsb(WS_X + 2 * ROWBUF);
    const float lam = lambda_full(F);
    const int G = (int)gridDim.x; const int vcu = (G % 8 == 0) ? ((int)blockIdx.x % 8) * (G / 8) + (int)blockIdx.x / 8 : (int)blockIdx.x;
    for (int p = vcu; p < BATCH * 8 * 2; p += G) {
        const int bh = p >> 1, s = p & 1, b = bh >> 3, h = bh & 7;
#pragma unroll 1
        for (int i = 0; i < 4; ++i) {
            const int qb = s == 0 ? (i == 0 ? 7 : (i == 1 ? 0 : (i == 2 ? 5 : 2))) : (i == 0 ? 6 : (i == 1 ? 1 : (i == 2 ? 4 : 3)));
            att2::attn_unit(qb, b, h, Qb, Kb, Vb, OA, lam, (char*)F.lds);
        }
    }
}

__device__ __forceinline__ void p9_attn_opt(Frame& F, bf16_t* O0, bf16_t* O1) {
    const bf16_t* Kb = F.wsb(WS_X); const bf16_t* Vb = F.wsb(WS_X + ROWBUF); const bf16_t* Qb = F.wsb(WS_X + 2 * ROWBUF);
    const int G = (int)gridDim.x; const int vcu = (G % 8 == 0) ? ((int)blockIdx.x % 8) * (G / 8) + (int)blockIdx.x / 8 : (int)blockIdx.x;
    for (int bh = vcu; bh < BATCH * 16; bh += G) {
        const int b = bh >> 4, hc = bh & 15, h = hc >> 1, c = hc & 1;
        bf16_t* Oc = c ? O1 : O0;
        for (int qi = 0; qi < 8; ++qi)
            for (int vh = 0; vh < 2; ++vh) {
                const int qb = qi;
                const long row0 = (long)b * SEQ + qb * 256;
                att::attn_unit<8>(qb, Qb + row0 * D + hc * 64, Kb + (long)META0 * D + hc * 64, Kb + (long)b * SEQ * D + hc * 64,
                                  Vb + (long)META0 * D + (2 * h + vh) * 64, Vb + (long)b * SEQ * D + (2 * h + vh) * 64, Oc + row0 * D + (2 * h + vh) * 64, (char*)F.lds);
            }
    }
}
__device__ __forceinline__ void p9_combine(Frame& F, const bf16_t* O0, const bf16_t* O1, bf16_t* OA) {
    const float lam = lambda_full(F);
    for (int r = F.gw; r < MMAIN; r += F.ngw) {
        const u32x4* a = (const u32x4*)(O0 + (size_t)r * D) + 2 * F.ln(); const u32x4* b = (const u32x4*)(O1 + (size_t)r * D) + 2 * F.ln();
        const u32x4 a0 = a[0], a1 = a[1], b0 = b[0], b1 = b[1];
        float o[16];
#pragma unroll
        for (int q = 0; q < 4; ++q) { o[2 * q] = bflo(a0[q]) - lam * bflo(b0[q]); o[2 * q + 1] = bfhi(a0[q]) - lam * bfhi(b0[q]); o[8 + 2 * q] = bflo(a1[q]) - lam * bflo(b1[q]); o[9 + 2 * q] = bfhi(a1[q]) - lam * bfhi(b1[q]); }
        float ss = 0.f;
#pragma unroll
        for (int q = 0; q < 16; ++q) ss += o[q] * o[q];
        ss += __shfl_xor(ss, 1); ss += __shfl_xor(ss, 2); ss += __shfl_xor(ss, 4);
        const float rr = 1.0f / sqrtf(ss * (1.f / 128.f) + SUBLN_EPS);
        u32x4* d = (u32x4*)(OA + (size_t)r * D) + 2 * F.ln();
        d[0] = (u32x4){pk2(o[0] * rr, o[1] * rr), pk2(o[2] * rr, o[3] * rr), pk2(o[4] * rr, o[5] * rr), pk2(o[6] * rr, o[7] * rr)};
        d[1] = (u32x4){pk2(o[8] * rr, o[9] * rr), pk2(o[10] * rr, o[11] * rr), pk2(o[12] * rr, o[13] * rr), pk2(o[14] * rr, o[15] * rr)};
    }
}

constexpr int NPH = 14;
#ifndef DUP_MASK
#define DUP_MASK 0
#endif
#ifndef MK_PER_PHASE
#define MK_PER_PHASE 0
#endif
#ifndef DUP_MASK
#define DUP_MASK 0
#endif
__global__ void __launch_bounds__(NTHR, 2) fwd(Args args) {
    extern __shared__ __attribute__((aligned(16))) unsigned char lds_raw[];
    Frame F;
    F.lds = (LAS unsigned char*)lds_raw;
    F.tid = threadIdx.x; F.wave = __builtin_amdgcn_readfirstlane(F.tid >> 6);
    F.gw = blockIdx.x * NWAVES + F.wave; F.ngw = gridDim.x * NWAVES;
    F.ws = args.ws; F.out = args.out; F.ctl = (unsigned*)(args.ws + WS_CTL);
#pragma unroll
    for (int i = 0; i < 22; ++i) F.in[i] = args.in[i];
    volatile LAS unsigned* MISC = (volatile LAS unsigned*)(F.lds + MISC_OFF);
    if (F.tid < 64) MISC[F.tid] = 0u;
    __syncthreads();
    XcdBarrier bar; bar.bar = F.ctl + CW_BAR; bar.x = 0; bar.st = nullptr;
    if (!MK_PER_PHASE) bar = xcd_barrier_post(F.ctl + CW_BAR, MISC + 8);
    const int lo = args.ph_lo, hi = args.ph_hi;
#define IN(k) (lo <= (k) && (k) < hi)
#define SEAM(k) do { if (IN(k) && IN((k) + 1)) xcd_barrier(bar); } while (0)
    unsigned* cnt0 = F.ctl + CW_CNT0; unsigned* cnt1 = F.ctl + CW_CNT1; float* ssq = (float*)(F.ws + WS_MISC + MISC_SSQ);
    bf16_t* OA = F.wsb(WS_X + 2 * ROWBUF);
    bf16_t* O0 = (bf16_t*)F.out; bf16_t* O1 = (bf16_t*)F.out + (size_t)MMAIN * D;
    const bool dry = (args.pad != 0);
    if (IN(0)) { p0_prologue(F); } SEAM(0);
    if (IN(1)) { p1_opt(F); } SEAM(1);
    if (IN(2)) { p2_conv(F); } SEAM(2);
    if (IN(3)) { p3_opt(F); } SEAM(3);
    if (IN(4)) { p_router(F, 0, NTOK0, F.rstd(1), cnt0, dry); } SEAM(4);
    if (IN(5)) { m1_run<(FP8_M1_MASK & 1) != 0, (FP8_MASK & 1) != 0>(F, 0, F.rstd(1), cnt0); } SEAM(5);
    if (IN(6)) { m2_run<(FP8_MASK & 1) != 0>(F, 0, cnt0, dry, ssq, nullptr); } SEAM(6);
    if (IN(7)) { p8_opt(F, ssq); } SEAM(7);
    if (IN(8)) { p9_attn2(F, OA); } SEAM(8);
    if (IN(9)) { p10_opt(F, OA, dry); } SEAM(9);
    if (IN(10)) { p_router(F, 1, MMAIN, F.rstd(3), cnt1, dry); } SEAM(10);
    if (IN(11)) { m1_run<(FP8_M1_MASK & 2) != 0, (FP8_MASK & 2) != 0>(F, 1, F.rstd(3), cnt1); } SEAM(11);
    if (IN(12)) { m2_run<(FP8_MASK & 2) != 0>(F, 1, cnt1, dry, nullptr, nullptr); } SEAM(12);
    if (IN(13)) { p_final(F, dry); }
#undef IN
#undef SEAM
}

extern "C" void kernel_launch(void* const* d_in, const int* in_sizes, int n_in, void* d_out, int out_size, void* d_ws, size_t ws_size, hipStream_t stream) {
    static int grid = 0;
    if (grid == 0) {
        int dev = 0, cus = 0;
        if (hipGetDevice(&dev) != hipSuccess || hipDeviceGetAttribute(&cus, hipDeviceAttributeMultiprocessorCount, dev) != hipSuccess) { grid = -1; return; }
        if (hipFuncSetAttribute((const void*)fwd, hipFuncAttributeMaxDynamicSharedMemorySize, LDS_BYTES) != hipSuccess) { fprintf(stderr, "kernel_launch: hipFuncSetAttribute failed\n"); grid = -1; return; }
        int per_cu = 0;
        if (hipOccupancyMaxActiveBlocksPerMultiprocessor(&per_cu, (const void*)fwd, NTHR, LDS_BYTES) != hipSuccess || per_cu < 1) fprintf(stderr, "kernel_launch: occupancy query says %d\n", per_cu);
        (void)hipGetLastError();
        grid = cus;
        if (n_in != 22 || ws_size < WS_END) { fprintf(stderr, "kernel_launch: unexpected n_in %d / ws_size %zu\n", n_in, ws_size); grid = -1; return; }
    }
    if (grid < 0) return;
    (void)hipMemsetAsync((char*)d_ws + WS_CTL, 0, CTL_BYTES, stream);
    Args a{};
    for (int i = 0; i < 22; ++i) a.in[i] = (const float*)d_in[i];
    a.out = (float*)d_out; a.ws = (unsigned char*)d_ws; a.pad = 0;
#if MK_PER_PHASE
    for (int p = 0; p < NPH; ++p) { a.ph_lo = p; a.ph_hi = p + 1; a.li = p;
        if ((DUP_MASK >> p) & 1) { a.pad = 1; hipLaunchKernelGGL(fwd, dim3(grid), dim3(NTHR), LDS_BYTES, stream, a); a.pad = 0; }
        hipLaunchKernelGGL(fwd, dim3(grid), dim3(NTHR), LDS_BYTES, stream, a); }
#else
    a.ph_lo = 0; a.ph_hi = NPH; a.li = 0;
    hipLaunchKernelGGL(fwd, dim3(grid), dim3(NTHR), LDS_BYTES, stream, a);
#endif
}
```

```cpp
#include <hip/hip_runtime.h>
#include <cstdio>
#include <cstdint>

#define GAS __attribute__((address_space(1)))
#define LAS __attribute__((address_space(3)))
typedef unsigned short bf16_t;
typedef short bf16x8 __attribute__((ext_vector_type(8)));
typedef float f32x4 __attribute__((ext_vector_type(4)));
typedef float f32x16 __attribute__((ext_vector_type(16)));
typedef unsigned u32x4 __attribute__((ext_vector_type(4)));
typedef unsigned u32x2 __attribute__((ext_vector_type(2)));

constexpr int D = 1024, BATCH = 16, SEQ = 2048, NMETA = 16;
constexpr int MMAIN = BATCH * SEQ;
constexpr int META0 = MMAIN;
constexpr int NTOK0 = MMAIN + NMETA;
constexpr int R = MMAIN + 256;
constexpr int ZROW = NTOK0;
constexpr int NCLS = 24, NEXP = 16, DE = 512;
constexpr float RMS_EPS = 1e-6f, SUBLN_EPS = 1e-5f;
constexpr float LOG2E = 1.4426950408889634f;
constexpr float QSCALE = 0.125f * LOG2E;
constexpr int NWAVES = 8, NTHR = 512;
#ifndef FP8_M1_MASK
#define FP8_M1_MASK 3
#endif
#ifndef FP8_MASK
#define FP8_MASK 3
#endif
constexpr float SA8 = 4.f, SW8 = 64.f, SH8 = 8.f, SWD8 = 32.f;

constexpr size_t MiB = 1u << 20;
constexpr size_t WS_CTL = 0, CTL_BYTES = 1 * MiB;
constexpr size_t WS_WIN = 1 * MiB;
constexpr size_t WS_WOUT = 7 * MiB;
constexpr size_t WS_WKVQ = 9 * MiB;
constexpr size_t WS_WO = 15 * MiB;
constexpr size_t WS_WEXP = 17 * MiB;
constexpr size_t WS_WR = 113 * MiB;
constexpr size_t WS_HMETA = 114 * MiB;
constexpr size_t WS_MISC = 115 * MiB;
constexpr size_t WS_HB = 123 * MiB;
constexpr size_t WS_H = 188 * MiB;
constexpr size_t WS_X = 265 * MiB;
constexpr size_t ROWBUF = (size_t)R * D * 2;
constexpr size_t WS_HB8 = 459 * MiB;
constexpr size_t WS_END = WS_HB8 + (size_t)R * D;
static_assert(WS_END <= 512 * MiB, "workspace");
constexpr size_t MISC_RSTD = 0;
constexpr size_t MISC_TOKW = 1 * MiB;
constexpr size_t MISC_TOKC = 1 * MiB + 512 * 1024;
constexpr size_t MISC_LIST = 2 * MiB;
constexpr size_t MISC_SSQ = 5 * MiB + 512 * 1024;
constexpr int CW_BAR = 4096;
constexpr int CW_CNT0 = 16384, CW_CNT1 = 16384 + 64 * 32;
constexpr int CW_SSQ = 131072;

__device__ __forceinline__ float bf2f(unsigned v) { return __uint_as_float(v << 16); }
__device__ __forceinline__ float bflo(unsigned v) { return __uint_as_float(v << 16); }
__device__ __forceinline__ float bfhi(unsigned v) { return __uint_as_float(v & 0xffff0000u); }
__device__ __forceinline__ unsigned pk2(float lo, float hi) { unsigned r; asm("v_cvt_pk_bf16_f32 %0, %1, %2" : "=v"(r) : "v"(lo), "v"(hi)); return r; }
__device__ __forceinline__ bf16_t f2bf(float f) { return (bf16_t)(pk2(f, 0.f) & 0xffffu); }
__device__ __forceinline__ int olane() { unsigned z = 0u; asm volatile("" : "+v"(z)); return (int)__builtin_amdgcn_mbcnt_hi(~0u, __builtin_amdgcn_mbcnt_lo(~0u, z)); }
__device__ __forceinline__ unsigned pk4_fp8(float a, float b, float c, float d) { int p = __builtin_amdgcn_cvt_pk_fp8_f32(a, b, 0, false); p = __builtin_amdgcn_cvt_pk_fp8_f32(c, d, p, true); return (unsigned)p; }
__device__ __forceinline__ float wave_sum(float v) {
#pragma unroll
    for (int o = 1; o < 64; o <<= 1) v += __shfl_xor(v, o);
    return v;
}
__device__ __forceinline__ float wave_max(float v) {
#pragma unroll
    for (int o = 1; o < 64; o <<= 1) v = fmaxf(v, __shfl_xor(v, o));
    return v;
}
__device__ __forceinline__ int crow(int r, int hi) { return (r & 3) + 8 * (r >> 2) + 4 * hi; }
__host__ __device__ __forceinline__ float lambda_init1() { return 0.8f - 0.6f * 0.7408182206817179f; }

#define XB_TMO      128
#define XB_XCNT(j)  (256  + 64 * (j))
#define XB_XSUB(j)  (1280 + 64 * (j))
#define XB_XGEN(j)  (2304 + 64 * (j))
#define XB_TOP      3328
#define XB_TOPGEN   3392
#define XCD_BAR_WORDS 3456
#define XB_SPIN_CAP (1u << 22)
__device__ __forceinline__ unsigned xb_ld(unsigned* p)              { return __hip_atomic_load(p, __ATOMIC_RELAXED, __HIP_MEMORY_SCOPE_AGENT); }
__device__ __forceinline__ unsigned xb_add(unsigned* p, unsigned v) { return __hip_atomic_fetch_add(p, v, __ATOMIC_RELAXED, __HIP_MEMORY_SCOPE_AGENT); }
__device__ __forceinline__ unsigned xb_xcc_id() { return (unsigned)__builtin_amdgcn_s_getreg((3 << 11) | 20) & 0xFu; }
#define XB_SPIN(cond, bar) do { unsigned _sp = 0; while (cond) { __builtin_amdgcn_s_sleep(1); \
    if ((++_sp & 255u) == 0u) { if (xb_ld(&(bar)[XB_TMO])) break; if (_sp > XB_SPIN_CAP) { atomicAdd(&(bar)[XB_TMO], 1u); break; } } } } while (0)
struct XcdBarrier { unsigned* bar; unsigned x; volatile LAS unsigned* st; };
__device__ __forceinline__ XcdBarrier xcd_barrier_post(unsigned* bar, volatile LAS unsigned* st) {
    XcdBarrier b; b.bar = bar; b.x = xb_xcc_id(); b.st = st;
    if (threadIdx.x == 0) (void)xb_add(&bar[XB_XCNT(b.x)], 1u);
    return b;
}
__device__ __forceinline__ void xcd_barrier_complete(unsigned* bar, unsigned x, unsigned& nloc, unsigned& nx) {
    const unsigned G = gridDim.x * gridDim.y * gridDim.z;
    unsigned sum, cnt, mine, sp = 0u;
    for (;;) {
        sum = 0u; cnt = 0u; mine = 0u;
#pragma unroll
        for (unsigned j = 0; j < 16; ++j) { const unsigned c = xb_ld(&bar[XB_XCNT(j)]); sum += c; cnt += (c > 0u) ? 1u : 0u; mine = (j == x) ? c : mine; }
        if (sum == G) break;
        __builtin_amdgcn_s_sleep(1);
        if ((++sp & 255u) == 0u) { if (xb_ld(&bar[XB_TMO])) break; if (sp > XB_SPIN_CAP) { atomicAdd(&bar[XB_TMO], 1u); break; } }
    }
    nloc = mine > 0u ? mine : 1u; nx = cnt > 0u ? cnt : 1u;
}
__device__ __forceinline__ void xcd_barrier(const XcdBarrier& b) {
    asm volatile("s_waitcnt vmcnt(0)" ::: "memory");
    __syncthreads();
    if (threadIdx.x == 0) {
        unsigned* bar = b.bar;
        __builtin_amdgcn_s_waitcnt(0);
        unsigned nloc = b.st[0], nx = b.st[1];
        if (nloc == 0u) { xcd_barrier_complete(bar, b.x, nloc, nx); b.st[0] = nloc; b.st[1] = nx; }
        const unsigned old = xb_add(&bar[XB_XSUB(b.x)], 1u);
        const unsigned gen = old / nloc;
        if (old + 1u == (gen + 1u) * nloc) {
            __builtin_amdgcn_fence(__ATOMIC_RELEASE, "agent");
            asm volatile("s_waitcnt vmcnt(0)" ::: "memory");
            const unsigned og = xb_add(&bar[XB_TOP], 1u);
            const unsigned tg = og / nx;
            if (og + 1u == (tg + 1u) * nx) xb_add(&bar[XB_TOPGEN], 1u);
            else XB_SPIN(xb_ld(&bar[XB_TOPGEN]) == tg, bar);
            __builtin_amdgcn_fence(__ATOMIC_ACQUIRE, "agent");
            xb_add(&bar[XB_XGEN(b.x)], 1u);
            asm volatile("s_waitcnt vmcnt(0)" ::: "memory");
        } else {
            XB_SPIN(xb_ld(&bar[XB_XGEN(b.x)]) == gen, bar);
            __builtin_amdgcn_fence(__ATOMIC_ACQUIRE, "agent");
            asm volatile("s_waitcnt vmcnt(0)" ::: "memory");
        }
    }
    __syncthreads();
}

constexpr int LDS_BYTES = 163840;
constexpr int MISC_OFF = 163584;
struct Args { const float* in[22]; float* out; unsigned char* ws; int ph_lo, ph_hi, li, pad; };
struct Frame {
    LAS unsigned char* lds;
    unsigned* ctl;
    int tid, wave, gw, ngw;
    __device__ __forceinline__ int ln() const { return olane(); }
    const float* in[22]; float* out; unsigned char* ws;
    __device__ __forceinline__ bf16_t* wsb(size_t off) const { return (bf16_t*)(ws + off); }
    __device__ __forceinline__ float* hrow(int r) const { return r < MMAIN ? out + (size_t)r * D : (float*)(ws + WS_HMETA) + (size_t)(r - MMAIN) * D; }
    __device__ __forceinline__ float* rstd(int i) const { return (float*)(ws + WS_MISC + MISC_RSTD + (size_t)i * 262144); }
    __device__ __forceinline__ float* tokw() const { return (float*)(ws + WS_MISC + MISC_TOKW); }
    __device__ __forceinline__ int* tokc() const { return (int*)(ws + WS_MISC + MISC_TOKC); }
    __device__ __forceinline__ int* list() const { return (int*)(ws + WS_MISC + MISC_LIST); }
    __device__ __forceinline__ bf16_t* wexp(int l, int e, int which) const { return (bf16_t*)(ws + WS_WEXP + ((size_t)((l * 16 + e) * 3 + which)) * MiB); }
};
enum { I_X = 0, I_META, I_ANORM, I_WIN, I_CONV, I_WOUT, I_KVNORM, I_WKV, I_BNORM, I_WQ, I_LAMBDA, I_SUBLN, I_WO, I_FFNNORM, I_RGW, I_RGB, I_REW, I_REB, I_WG, I_WU, I_WD, I_FNORM };

__device__ __forceinline__ int win_row(int n) {
    if (n < 1024) return n;
    if (n < 2048) { const int j = n - 1024; return 1024 + (j >> 7) * 256 + (j & 127); }
    const int j = n - 2048; return 1024 + (j >> 7) * 256 + 128 + (j & 127);
}
struct TrJob { const float* W; const float* gain; bf16_t* WT; int K, N, gmask, row_off, mode, item, f8; float gscale; };
__device__ __forceinline__ TrJob tr_decode(Frame& F, int it) {
    constexpr int IT_EXP = 96 * 256, IT_WIN = 16 * 96, IT_WOUT = 16 * 32, IT_WKV = 16 * 64, IT_WQ = 16 * 32;
    TrJob j; j.gain = nullptr; j.gmask = 1023; j.row_off = 0; j.mode = 0; j.gscale = 1.f; j.f8 = 0; int r = it;
    if (r < IT_EXP) { const int m = r >> 8, l = m / 48, e = (m % 48) / 3, which = m % 3; j.item = r & 255;
        if (which == 2) { j.W = F.in[I_WD] + (size_t)(l * 16 + e) * DE * D; j.K = DE; j.N = D; }
        else { j.W = (which == 0 ? F.in[I_WG] : F.in[I_WU]) + (size_t)(l * 16 + e) * D * DE; j.K = D; j.N = DE; j.gain = F.in[I_FFNNORM] + l * D; }
        j.WT = F.wexp(l, e, which); if (which == 2 ? ((FP8_MASK >> l) & 1) : ((FP8_M1_MASK >> l) & 1)) { j.f8 = 1; j.gscale = which == 2 ? SWD8 : SW8; } return j; }
    r -= IT_EXP;
    if (r < IT_WIN) { j.W = F.in[I_WIN]; j.K = D; j.N = 3 * D; j.gain = F.in[I_ANORM]; j.WT = F.wsb(WS_WIN); j.mode = 1; j.item = r; return j; } r -= IT_WIN;
    if (r < IT_WOUT) { j.W = F.in[I_WOUT]; j.K = D; j.N = D; j.WT = F.wsb(WS_WOUT); j.item = r; return j; } r -= IT_WOUT;
    if (r < IT_WKV) { j.W = F.in[I_WKV]; j.K = D; j.N = 2 * D; j.gain = F.in[I_KVNORM]; j.WT = F.wsb(WS_WKVQ); j.item = r; return j; } r -= IT_WKV;
    if (r < IT_WQ) { j.W = F.in[I_WQ]; j.K = D; j.N = D; j.gain = F.in[I_BNORM]; j.WT = F.wsb(WS_WKVQ); j.row_off = 2 * D; j.item = r; return j; } r -= IT_WQ;
    j.W = F.in[I_WO]; j.K = D; j.N = D; j.gain = F.in[I_SUBLN]; j.gmask = 127; j.gscale = 1.f - lambda_init1(); j.WT = F.wsb(WS_WO); j.item = r; return j;
}
__device__ __forceinline__ void tr_load(const TrJob& j, float (&v)[32], int lane) {
    const int nblk = j.N / 32, kb = j.item / nblk, nb = j.item % nblk;
    const float* src = j.W + (size_t)(64 * kb + (lane >> 5)) * j.N + 32 * nb + (lane & 31);
#pragma unroll
    for (int i = 0; i < 32; ++i) v[i] = src[(size_t)(2 * i) * j.N];
}
__device__ __forceinline__ void tr_to_lds(const float (&v)[32], LAS float* scr, int lane) {
#pragma unroll
    for (int i = 0; i < 32; ++i) scr[(2 * i + (lane >> 5)) * 33 + (lane & 31)] = v[i];
}
__device__ __forceinline__ void tr_store(const TrJob& j, LAS float* scr, int lane) {
    const int nblk = j.N / 32, kb = j.item / nblk, nb = j.item % nblk, k0 = 64 * kb, n0 = 32 * nb;
    const int c = lane & 7;
    float g[8];
#pragma unroll
    for (int i = 0; i < 8; ++i) g[i] = (j.gain ? j.gain[(k0 + 8 * c + i) & j.gmask] : 1.f) * j.gscale;
#pragma unroll
    for (int q = 0; q < 4; ++q) { const int n = (lane >> 3) + 8 * q; const LAS float* s = scr + (8 * c) * 33 + n;
        const int nn = n0 + n; const int drow = (j.mode == 1) ? win_row(nn) : j.row_off + nn;
        if (j.f8) { u32x2 o; o.x = pk4_fp8(s[0 * 33] * g[0], s[1 * 33] * g[1], s[2 * 33] * g[2], s[3 * 33] * g[3]); o.y = pk4_fp8(s[4 * 33] * g[4], s[5 * 33] * g[5], s[6 * 33] * g[6], s[7 * 33] * g[7]);
            *(u32x2*)((unsigned char*)j.WT + (size_t)drow * j.K + k0 + 8 * c) = o; }
        else { u32x4 o; o.x = pk2(s[0 * 33] * g[0], s[1 * 33] * g[1]); o.y = pk2(s[2 * 33] * g[2], s[3 * 33] * g[3]); o.z = pk2(s[4 * 33] * g[4], s[5 * 33] * g[5]); o.w = pk2(s[6 * 33] * g[6], s[7 * 33] * g[7]);
            *(u32x4*)(j.WT + (size_t)drow * j.K + k0 + 8 * c) = o; } }
}
__device__ __forceinline__ void p0_prologue(Frame& F) {
    LAS float* scr = (LAS float*)(F.lds + F.wave * 16384);
    constexpr int NITEMS = 96 * 256 + 16 * 96 + 16 * 32 + 16 * 64 + 16 * 32 + 16 * 32;
    { float v[32]; int it = F.gw; TrJob cur; if (it < NITEMS) { cur = tr_decode(F, it); tr_load(cur, v, F.ln()); }
      while (it < NITEMS) {
          tr_to_lds(v, scr, F.ln());
          const int nx = it + F.ngw; TrJob nj; if (nx < NITEMS) { nj = tr_decode(F, nx); tr_load(nj, v, F.ln()); }
          asm volatile("s_waitcnt lgkmcnt(0)" ::: "memory");
          tr_store(cur, scr, F.ln());
          asm volatile("s_waitcnt lgkmcnt(0)" ::: "memory");
          cur = nj; it = nx; } }
    { u32x4* wrf = (u32x4*)(F.ws + WS_WR);
      for (int idx = F.gw * 64 + F.ln(); idx < 2 * 32 * 2 * 64; idx += F.ngw * 64) { const int l = idx >> 12, s = (idx >> 7) & 31, cb = (idx >> 6) & 1, ln = idx & 63; const int col = cb * 16 + (ln & 15), kq = ln >> 4;
          float w[8];
#pragma unroll
          for (int e = 0; e < 8; ++e) { const int k = 32 * s + 8 * kq + e; float v = 0.f;
              if (col < 20) v = F.in[I_FFNNORM][l * D + k] * ((col < 4) ? F.in[I_RGW][(size_t)(l * D + k) * 4 + col] : F.in[I_REW][(size_t)(l * D + k) * 16 + (col - 4)]);
              w[e] = v; }
          const u32x4 hi = (u32x4){pk2(w[0], w[1]), pk2(w[2], w[3]), pk2(w[4], w[5]), pk2(w[6], w[7])};
          const u32x4 lo = (u32x4){pk2(w[0] - bflo(hi.x), w[1] - bfhi(hi.x)), pk2(w[2] - bflo(hi.y), w[3] - bfhi(hi.y)), pk2(w[4] - bflo(hi.z), w[5] - bfhi(hi.z)), pk2(w[6] - bflo(hi.w), w[7] - bfhi(hi.w))};
          u32x4* dst = wrf + (size_t)l * 8192 + ((s * 2 + cb) * 2) * 64 + ln; dst[0] = hi; dst[64] = lo; } }
    bf16_t* hb = F.wsb(WS_HB); float* rs = F.rstd(0);
    for (int r = F.gw; r < R; r += F.ngw) {
        GAS unsigned long long* o8 = (GAS unsigned long long*)(hb + (size_t)r * D) + F.ln();
        if (r >= NTOK0) {
            if (FP8_M1_MASK) ((GAS u32x4*)(F.ws + WS_HB8 + (size_t)r * D))[F.ln()] = (u32x4){0u, 0u, 0u, 0u};
#pragma unroll
            for (int j = 0; j < 4; ++j) o8[64 * j] = 0ull;
            if (F.ln() == 0) rs[r] = 0.f;
            continue;
        }
        const float* src = r < MMAIN ? F.in[I_X] + (size_t)r * D : F.in[I_META] + (size_t)(r - MMAIN) * D;
        const GAS f32x4* xr = (const GAS f32x4*)src + F.ln();
        f32x4 v[4]; float s = 0.f;
#pragma unroll
        for (int j = 0; j < 4; ++j) { v[j] = xr[64 * j]; s += (v[j].x * v[j].x + v[j].y * v[j].y) + (v[j].z * v[j].z + v[j].w * v[j].w); }
        s = wave_sum(s);
#pragma unroll
        for (int j = 0; j < 4; ++j) o8[64 * j] = (unsigned long long)pk2(v[j].x, v[j].y) | ((unsigned long long)pk2(v[j].z, v[j].w) << 32);
        if (F.ln() == 0) rs[r] = 1.0f / sqrtf(s * (1.f / D) + RMS_EPS);
    }
}

__device__ __forceinline__ void p2_conv(Frame& F) {
    const bf16_t* Bb = F.wsb(WS_X); const bf16_t* Zb = F.wsb(WS_X + ROWBUF); bf16_t* G = F.wsb(WS_X + 2 * ROWBUF); const float* cw = F.in[I_CONV];
    const int tid = F.wave * 64 + F.ln(); const int c8 = (tid & 127) * 8, rsub = tid >> 7;
    float w0[8], w1[8], w2[8];
#pragma unroll
    for (int q = 0; q < 2; ++q) { const f32x4 a = *(const f32x4*)(cw + c8 + 4 * q), b = *(const f32x4*)(cw + D + c8 + 4 * q), c = *(const f32x4*)(cw + 2 * D + c8 + 4 * q);
#pragma unroll
        for (int e = 0; e < 4; ++e) { w0[4 * q + e] = a[e]; w1[4 * q + e] = b[e]; w2[4 * q + e] = c[e]; } }
    const int nblk = R / 8;
    for (int blk = blockIdx.x * 4 + rsub; blk < nblk; blk += gridDim.x * 4) {
        const int r0 = blk * 8;
        if (r0 >= NTOK0) {
#pragma unroll
            for (int i = 0; i < 8; ++i) *(u32x4*)(G + (size_t)(r0 + i) * D + c8) = (u32x4){0u, 0u, 0u, 0u};
            continue; }
        int p1, p2;
        if (r0 < MMAIN) { const int s = r0 & (SEQ - 1); p1 = s >= 1 ? r0 - 1 : META0 + 15; p2 = s >= 2 ? r0 - 2 : META0 + 14; }
        else { p1 = r0 > META0 ? r0 - 1 : -1; p2 = r0 > META0 ? r0 - 2 : -1; }
        u32x4 zm2 = p2 >= 0 ? *(const u32x4*)(Zb + (size_t)p2 * D + c8) : (u32x4){0u, 0u, 0u, 0u};
        u32x4 zm1 = p1 >= 0 ? *(const u32x4*)(Zb + (size_t)p1 * D + c8) : (u32x4){0u, 0u, 0u, 0u};
        u32x4 zr[8], br[8];
#pragma unroll
        for (int i = 0; i < 8; ++i) { zr[i] = *(const u32x4*)(Zb + (size_t)(r0 + i) * D + c8); br[i] = *(const u32x4*)(Bb + (size_t)(r0 + i) * D + c8); }
#pragma unroll
        for (int i = 0; i < 8; ++i) { const u32x4 z0 = zr[i], z1 = i >= 1 ? zr[i - 1] : zm1, z2 = i >= 2 ? zr[i - 2] : (i == 1 ? zm1 : zm2); const u32x4 bv = br[i];
            float g[8];
#pragma unroll
            for (int q = 0; q < 4; ++q) {
                g[2 * q] = bflo(bv[q]) * (w0[2 * q] * bflo(z2[q]) + w1[2 * q] * bflo(z1[q]) + w2[2 * q] * bflo(z0[q]));
                g[2 * q + 1] = bfhi(bv[q]) * (w0[2 * q + 1] * bfhi(z2[q]) + w1[2 * q + 1] * bfhi(z1[q]) + w2[2 * q + 1] * bfhi(z0[q])); }
            *(u32x4*)(G + (size_t)(r0 + i) * D + c8) = (u32x4){pk2(g[0], g[1]), pk2(g[2], g[3]), pk2(g[4], g[5]), pk2(g[6], g[7])}; }
    }
}
__device__ __forceinline__ void cls_experts(int cls, int& elo, int& ehi) { const int g = cls / 6, p = cls % 6; const int lo = p < 3 ? 0 : (p < 5 ? 1 : 2), hi = p < 3 ? p + 1 : (p < 5 ? p - 1 : 3); elo = 4 * g + lo; ehi = 4 * g + hi; }
__device__ __forceinline__ float silu(float g) { return g / (1.f + __expf(-g)); }

constexpr int RT_SCR = 131072, RT_HIST = RT_SCR + 8 * 1536;
__device__ __forceinline__ void p_router(Frame& F, int layer, int ntok, float* rstd_out, unsigned* cnt, bool dry) {
    const u32x4* wrf = (const u32x4*)(F.ws + WS_WR) + (size_t)layer * 8192;
    const float* bg = F.in[I_RGB] + layer * 4; const float* be = F.in[I_REB] + layer * 16;
    float* tw = F.tokw(); int* lst = F.list();
    LAS u32x4* bfr = (LAS u32x4*)F.lds;
    { u32x4 tmp[16];
#pragma unroll
      for (int i = 0; i < 16; ++i) tmp[i] = wrf[F.tid + 512 * i];
#pragma unroll
      for (int i = 0; i < 16; ++i) bfr[F.tid + 512 * i] = tmp[i]; }
    LAS int* hist = (LAS int*)(F.lds + RT_HIST);
    LAS float* scr = (LAS float*)(F.lds + RT_SCR + F.wave * 1536);
    const bf16_t* hb = F.wsb(WS_HB);
    const int ntiles = (ntok + 127) >> 7;
    for (int tile = blockIdx.x; tile < ntiles; tile += gridDim.x) {
        __syncthreads();
        if (F.tid < 64) hist[F.tid] = 0;
        __syncthreads();
        const int row = tile * 128 + F.wave * 16 + (F.ln() & 15); const bool rvalid = row < ntok; const int kq = F.ln() >> 4;
        const u32x4* ap = (const u32x4*)(hb + (size_t)(rvalid ? row : ZROW) * D) + kq;
        u32x4 a[32];
#pragma unroll
        for (int s = 0; s < 32; ++s) a[s] = ap[4 * s];
        f32x4 acc0 = (f32x4){0.f, 0.f, 0.f, 0.f}, acc1 = acc0; float ss = 0.f;
#pragma unroll
        for (int s = 0; s < 32; ++s) {
            const LAS u32x4* bp = bfr + (s * 4) * 64 + F.ln();
            const bf16x8 av = __builtin_bit_cast(bf16x8, a[s]);
            acc0 = __builtin_amdgcn_mfma_f32_16x16x32_bf16(av, __builtin_bit_cast(bf16x8, bp[0]), acc0, 0, 0, 0);
            acc1 = __builtin_amdgcn_mfma_f32_16x16x32_bf16(av, __builtin_bit_cast(bf16x8, bp[128]), acc1, 0, 0, 0);
            acc0 = __builtin_amdgcn_mfma_f32_16x16x32_bf16(av, __builtin_bit_cast(bf16x8, bp[64]), acc0, 0, 0, 0);
            acc1 = __builtin_amdgcn_mfma_f32_16x16x32_bf16(av, __builtin_bit_cast(bf16x8, bp[192]), acc1, 0, 0, 0);
#pragma unroll
            for (int q = 0; q < 4; ++q) { const float x0 = bflo(a[s][q]), x1 = bfhi(a[s][q]); ss += x0 * x0 + x1 * x1; }
        }
        ss += __shfl_xor(ss, 16); ss += __shfl_xor(ss, 32);
#pragma unroll
        for (int r = 0; r < 4; ++r) { scr[(4 * kq + r) * 24 + (F.ln() & 15)] = acc0[r]; if ((F.ln() & 15) < 8) scr[(4 * kq + r) * 24 + 16 + (F.ln() & 15)] = acc1[r]; }
        asm volatile("s_waitcnt lgkmcnt(0)" ::: "memory");
        int cls = 0, slot = 0; float rstd = 0.f, wlo = 0.f, whi = 0.f;
        const bool router_lane = F.ln() < 16 && rvalid;
        if (router_lane) {
            rstd = 1.0f / sqrtf(ss * (1.f / D) + RMS_EPS);
            float dt[20];
#pragma unroll
            for (int q = 0; q < 20; ++q) dt[q] = scr[F.ln() * 24 + q] * rstd;
            float lg[4];
#pragma unroll
            for (int q = 0; q < 4; ++q) lg[q] = dt[q] + bg[q];
            int g = 0; float mg = lg[0];
#pragma unroll
            for (int q = 1; q < 4; ++q) if (lg[q] > mg) { mg = lg[q]; g = q; }
            float den = 0.f;
#pragma unroll
            for (int q = 0; q < 4; ++q) den += __expf(lg[q] - mg);
            const float psel = 1.0f / den;
            float le[4];
#pragma unroll
            for (int q = 0; q < 4; ++q) { const float d0 = dt[4 + q] + be[q], d1 = dt[8 + q] + be[4 + q], d2 = dt[12 + q] + be[8 + q], d3 = dt[16 + q] + be[12 + q];
                le[q] = g == 0 ? d0 : (g == 1 ? d1 : (g == 2 ? d2 : d3)); }
            int i1 = 0; float v1 = le[0];
#pragma unroll
            for (int q = 1; q < 4; ++q) if (le[q] > v1) { v1 = le[q]; i1 = q; }
            int i2 = -1; float v2 = -INFINITY;
#pragma unroll
            for (int q = 0; q < 4; ++q) if (q != i1 && le[q] > v2) { v2 = le[q]; i2 = q; }
            const float e2 = __expf(v2 - v1); const float w1 = psel / (1.f + e2), w2 = psel * e2 / (1.f + e2);
            const int lo = i1 < i2 ? i1 : i2, hi = i1 < i2 ? i2 : i1;
            const int pidx = lo == 0 ? hi - 1 : (lo == 1 ? hi + 1 : 5);
            cls = g * 6 + pidx; wlo = i1 < i2 ? w1 : w2; whi = i1 < i2 ? w2 : w1;
            slot = __hip_atomic_fetch_add((int*)(hist + cls), 1, __ATOMIC_RELAXED, __HIP_MEMORY_SCOPE_WORKGROUP);
        }
        __syncthreads();
        if (F.tid < NCLS && !dry) { const int n = hist[F.tid]; hist[32 + F.tid] = n ? (int)atomicAdd(cnt + 64 * F.tid, (unsigned)n) : 0; }
        __syncthreads();
        if (router_lane && !dry) { const int pos = hist[32 + cls] + slot; lst[(size_t)cls * R + pos] = row; rstd_out[row] = rstd; tw[2 * row] = wlo; tw[2 * row + 1] = whi; }
    }
    __syncthreads();
}
__device__ __forceinline__ void p_rowstat(Frame& F, float* rstd_out) {
    const bf16_t* hb = F.wsb(WS_HB);
    for (int r = F.gw; r < R; r += F.ngw) {
        const u32x4* xr = (const u32x4*)(hb + (size_t)r * D) + F.ln(); const u32x4 a = xr[0], b = xr[64]; float s = 0.f;
#pragma unroll
        for (int q = 0; q < 4; ++q) { s += bflo(a[q]) * bflo(a[q]) + bfhi(a[q]) * bfhi(a[q]); s += bflo(b[q]) * bflo(b[q]) + bfhi(b[q]) * bfhi(b[q]); }
        s = wave_sum(s);
        if (F.ln() == 0) rstd_out[r] = 1.0f / sqrtf(s * (1.f / D) + RMS_EPS);
    }
}
__device__ __forceinline__ float lambda_full(Frame& F) {
    const float* lm = F.in[I_LAMBDA]; const int l = F.ln();
    const float a = wave_sum(lm[l] * lm[64 + l]), b = wave_sum(lm[128 + l] * lm[192 + l]);
    return __expf(a) - __expf(b) + lambda_init1();
}
__device__ __forceinline__ void p_final(Frame& F, bool dry) {
    const bf16_t* hb = F.wsb(WS_HB); const float* gn = F.in[I_FNORM];
    const f32x4 g0 = *(const f32x4*)(gn + 8 * F.ln()), g1 = *(const f32x4*)(gn + 8 * F.ln() + 4), g2 = *(const f32x4*)(gn + 512 + 8 * F.ln()), g3 = *(const f32x4*)(gn + 512 + 8 * F.ln() + 4);
    for (int r = F.gw; r < MMAIN; r += F.ngw) {
        const u32x4* xr = (const u32x4*)(hb + (size_t)r * D) + F.ln(); const u32x4 a = xr[0], b = xr[64];
        f32x4 v0 = (f32x4){bflo(a.x), bfhi(a.x), bflo(a.y), bfhi(a.y)}, v1 = (f32x4){bflo(a.z), bfhi(a.z), bflo(a.w), bfhi(a.w)};
        f32x4 v2 = (f32x4){bflo(b.x), bfhi(b.x), bflo(b.y), bfhi(b.y)}, v3 = (f32x4){bflo(b.z), bfhi(b.z), bflo(b.w), bfhi(b.w)};
        float s = (v0.x * v0.x + v0.y * v0.y) + (v0.z * v0.z + v0.w * v0.w) + (v1.x * v1.x + v1.y * v1.y) + (v1.z * v1.z + v1.w * v1.w)
                + (v2.x * v2.x + v2.y * v2.y) + (v2.z * v2.z + v2.w * v2.w) + (v3.x * v3.x + v3.y * v3.y) + (v3.z * v3.z + v3.w * v3.w);
        s = wave_sum(s); const float rstd = 1.0f / sqrtf(s * (1.f / D) + RMS_EPS);
        if (!dry) { f32x4* o = (f32x4*)(F.out + (size_t)r * D + 8 * F.ln());
            o[0] = v0 * rstd * g0; o[1] = v1 * rstd * g1; o[128] = v2 * rstd * g2; o[129] = v3 * rstd * g3; }
    }
}

#ifndef GP_SKEW_TICKS
#define GP_SKEW_TICKS 0
#endif
namespace gp {
typedef int v4i32 __attribute__((ext_vector_type(4))); typedef int v8i32 __attribute__((ext_vector_type(8)));
constexpr int BM = 256, BK = 64, HALF = 128, HTB = HALF * BK * 2, STAGE_BYTES = 8 * HTB, NXCD = 8, WGM = 8;
__host__ __device__ __forceinline__ int lds_byte(int r, int c) { const int st = (r >> 4) * 2 + (c >> 5), rr = r & 15, cc = c & 31, ob = rr * 64 + cc * 2; return st * 1024 + (ob ^ (((ob >> 9) & 1) << 5)); }
__host__ __device__ __forceinline__ void stage_rc(int b, int& R_, int& C_) { const int st = b / 1024, sb = b % 1024, swz = sb ^ (((sb >> 9) & 1) << 5); R_ = (st >> 1) * 16 + swz / 64; C_ = (st & 1) * 32 + (swz % 64) / 2; }
__host__ __device__ __forceinline__ int perm32(int rho) { const int n = rho >> 4, i = rho & 15; return 8 * (i >> 2) + 4 * n + (i & 3); }

struct Unit {
    unsigned b0, b1;
    int bd; int ks;
    int pm, pn;
    int x0, x1;
    int par;
};
__device__ __forceinline__ bool static_order(int i, int G, int c, int nM, int nN, int& pm, int& pn) {
    const int nwg = nM * nN; const int L = i * G + c; if (L >= nwg) return false;
    int wgid = L; { const int q = nwg / NXCD, r = nwg % NXCD, xcd = wgid % NXCD, off = wgid / NXCD; wgid = (xcd < r ? xcd * (q + 1) : r * (q + 1) + (xcd - r) * q) + off; }
    const int nig = WGM * nN, gid = wgid / nig, fm = gid * WGM, gsz = (nM - fm) < WGM ? (nM - fm) : WGM;
    pm = fm + ((wgid % nig) % gsz); pn = (wgid % nig) / gsz; return true;
}
__device__ __forceinline__ void bdma16(__amdgpu_buffer_rsrc_t rs, unsigned voff, unsigned soff, LAS void* l) { __builtin_amdgcn_raw_ptr_buffer_load_lds(rs, l, 16, (int)voff, (int)soff, 0, 0); }

template <class Epi, class Sched, int NT, bool F8 = false, bool ALIGN_EPI = true>
__device__ __forceinline__ void gemm_phase(LAS unsigned char* lds, int wid_in  , unsigned char* ws, unsigned Aoff  , int ldb_bytes  , Sched& S, const Epi& E) {
    constexpr bool GATHER = Sched::GATHER;
    const __amdgpu_buffer_rsrc_t rsrc = __builtin_amdgcn_make_buffer_rsrc((void*)ws, 0, 0x7fffffff, 0x00020000);
    const int wid = wid_in, wr = wid >> 2, wc = wid & 3; const int lane = olane(), tid = wid * 64 + lane, fr = lane & 15, fq = lane >> 4;
    unsigned voffB[2], voffA[2];
#pragma unroll
    for (int i = 0; i < 2; ++i) { int R_, C_; stage_rc(tid * 16 + i * 8192, R_, C_); const int Rb = Epi::PERM ? ((R_ & ~31) + perm32(R_ & 31)) : R_; voffB[i] = (unsigned)(Rb * ldb_bytes + C_ * 2);
        if constexpr (!GATHER) voffA[i] = (unsigned)(R_ * S.a_pitch() + C_ * 2); }
    const unsigned kstep = (unsigned)(BK * 2);
    const unsigned ldsw = (unsigned)wid * 1024u;
    const int aoff = lds_byte(wr * 64 + fr, fq * 8), boff = lds_byte(wc * 32 + fr, fq * 8);
#define GP_SA(b, h) (((b) * 2 + (h)) * HTB)
#define GP_SB(b, h) ((4 + (b) * 2 + (h)) * HTB)
#define GP_STAGE_B(bufoff, gbase) do { bdma16(rsrc, voffB[0], (gbase), lds + (bufoff) + ldsw); bdma16(rsrc, voffB[1], (gbase), lds + (bufoff) + ldsw + 8192); } while (0)
#define GP_STAGE_A(bufoff, h, koff) do { \
        if constexpr (GATHER) { bdma16(rsrc, co[h][0], Aoff + (koff), lds + (bufoff) + ldsw); bdma16(rsrc, co[h][1], Aoff + (koff), lds + (bufoff) + ldsw + 8192); } \
        else { const unsigned g_ = Aoff + cAu[h] + (koff); bdma16(rsrc, voffA[0], g_, lds + (bufoff) + ldsw); bdma16(rsrc, voffA[1], g_, lds + (bufoff) + ldsw + 8192); } } while (0)
#define GP_LDA(dst, b, h) do { if constexpr (F8) { _Pragma("unroll") for (int m = 0; m < 4; ++m) { const v4i32 lo_ = *(const LAS v4i32*)(lds + GP_SA(b, h) + aoff + m * 2048), hi_ = *(const LAS v4i32*)(lds + GP_SA(b, h) + aoff + m * 2048 + 1024); \
            dst##8[m] = __builtin_shufflevector(lo_, hi_, 0, 1, 2, 3, 4, 5, 6, 7); } } \
        else { _Pragma("unroll") for (int m = 0; m < 4; ++m) _Pragma("unroll") for (int k = 0; k < 2; ++k) dst[m][k] = *(const LAS bf16x8*)(lds + GP_SA(b, h) + aoff + m * 2048 + k * 1024); } } while (0)
#define GP_LDB(dst, b, h) do { if constexpr (F8) { _Pragma("unroll") for (int n = 0; n < 2; ++n) { const v4i32 lo_ = *(const LAS v4i32*)(lds + GP_SB(b, h) + boff + n * 2048), hi_ = *(const LAS v4i32*)(lds + GP_SB(b, h) + boff + n * 2048 + 1024); \
            dst##8[n] = __builtin_shufflevector(lo_, hi_, 0, 1, 2, 3, 4, 5, 6, 7); } } \
        else { _Pragma("unroll") for (int n = 0; n < 2; ++n) _Pragma("unroll") for (int k = 0; k < 2; ++k) dst[n][k] = *(const LAS bf16x8*)(lds + GP_SB(b, h) + boff + n * 2048 + k * 1024); } } while (0)
#define GP_MMA(ai, bj, At, Bt) do { __builtin_amdgcn_s_setprio(1); \
        if constexpr (F8) { _Pragma("unroll") for (int m = 0; m < 4; ++m) _Pragma("unroll") for (int n = 0; n < 2; ++n) \
            acc[ai][bj][m][n] = __builtin_amdgcn_mfma_scale_f32_16x16x128_f8f6f4(Bt##8[n], At##8[m], acc[ai][bj][m][n], 0, 0, 0, 0x7f7f7f7f, 0, 0x7f7f7f7f); } \
        else { _Pragma("unroll") for (int m = 0; m < 4; ++m) _Pragma("unroll") for (int n = 0; n < 2; ++n) _Pragma("unroll") for (int k = 0; k < 2; ++k) \
            acc[ai][bj][m][n] = __builtin_amdgcn_mfma_f32_16x16x32_bf16(Bt[n][k], At[m][k], acc[ai][bj][m][n], 0, 0, 0); } \
        __builtin_amdgcn_s_setprio(0); } while (0)
#define GP_WAIT_V(n) asm volatile("s_waitcnt vmcnt(" #n ")" ::: "memory")
#define GP_WAIT_L(n) asm volatile("s_waitcnt lgkmcnt(" #n ")" ::: "memory")
#define GP_BAR __builtin_amdgcn_s_barrier()
#define GP_SCHED __builtin_amdgcn_sched_barrier(0)
#define GP_BPTR(u, h, t) (((h) ? (u).b1 : (u).b0) + (unsigned)(t) * kstep + (unsigned)(((t) >= (u).ks) ? (u).bd : 0))
    Unit cur, nxt; int ui = 0;
    if (!S.next(0, cur)) return;
    f32x4 acc[2][2][4][2];
#pragma unroll
    for (int a = 0; a < 2; ++a)
#pragma unroll
        for (int b = 0; b < 2; ++b)
#pragma unroll
            for (int m = 0; m < 4; ++m)
#pragma unroll
                for (int n = 0; n < 2; ++n) acc[a][b][m][n] = (f32x4){0.f, 0.f, 0.f, 0.f};
    bf16x8 At[4][2], B0[2][2], B1[2][2]; v8i32 At8[4], B08[2], B18[2];
    unsigned co[2][2];
    unsigned cAu[2];
    if constexpr (GATHER) S.a_rows(cur, tid, co); else { cAu[0] = S.a_half(cur, 0); cAu[1] = S.a_half(cur, 1); }
    if constexpr (Sched::ROWIMG) { cur.par = 1; S.rows_prefetch(cur, rsrc, lds, 1, wid, lane); }
    GP_STAGE_B(GP_SB(0, 0), GP_BPTR(cur, 0, 0)); GP_STAGE_B(GP_SB(0, 1), GP_BPTR(cur, 1, 0)); GP_STAGE_A(GP_SA(0, 0), 0, 0u); GP_STAGE_A(GP_SA(0, 1), 1, 0u);
    if (wr == 1) GP_BAR;
    GP_WAIT_V(2); GP_BAR;
    GP_STAGE_B(GP_SB(1, 0), GP_BPTR(cur, 0, 1)); GP_STAGE_A(GP_SA(1, 0), 0, kstep); GP_STAGE_B(GP_SB(1, 1), GP_BPTR(cur, 1, 1));
    GP_WAIT_V(6); GP_BAR;
    for (;;) {
        const bool has_next = S.next(ui + 1, nxt);
        if (!has_next) nxt = cur;
        if constexpr (Sched::ROWIMG) { nxt.par = ui & 1; if (has_next) S.rows_prefetch(nxt, rsrc, lds, ui & 1, wid, olane()); }
#pragma nounroll
        for (int t = 0; t < NT; t += 2) {
            const bool last = (t == NT - 2);
            unsigned b2_0, b2_1, b3_0, b3_1, k2;
            if (last) { k2 = 0; b2_0 = GP_BPTR(nxt, 0, 0); b2_1 = GP_BPTR(nxt, 1, 0); b3_0 = GP_BPTR(nxt, 0, 1); b3_1 = GP_BPTR(nxt, 1, 1); }
            else { k2 = (unsigned)(t + 2) * kstep; b2_0 = GP_BPTR(cur, 0, t + 2); b2_1 = GP_BPTR(cur, 1, t + 2); b3_0 = GP_BPTR(cur, 0, t + 3); b3_1 = GP_BPTR(cur, 1, t + 3); }
            GP_LDB(B0, 0, 0); GP_LDB(B1, 0, 1); GP_SCHED; GP_LDA(At, 0, 0); GP_STAGE_A(GP_SA(1, 1), 1, (unsigned)(t + 1) * kstep);
            GP_WAIT_V(8); GP_WAIT_L(0); GP_BAR; GP_MMA(0, 0, At, B0); GP_MMA(0, 1, At, B1); GP_BAR; GP_SCHED;
            if (last && has_next) { if constexpr (GATHER) S.rows_from_lds(nxt, lds, ui & 1, wid * 64 + olane(), co); else { cAu[0] = S.a_half(nxt, 0); cAu[1] = S.a_half(nxt, 1); } }
            GP_LDA(At, 0, 1); GP_STAGE_B(GP_SB(0, 0), b2_0); GP_STAGE_B(GP_SB(0, 1), b2_1); GP_STAGE_A(GP_SA(0, 0), 0, k2);
            GP_WAIT_V(8); GP_WAIT_L(0); GP_BAR; GP_MMA(1, 0, At, B0); GP_MMA(1, 1, At, B1); GP_BAR; GP_SCHED;
            GP_LDB(B0, 1, 0); GP_LDB(B1, 1, 1); GP_SCHED; GP_LDA(At, 1, 0); GP_STAGE_A(GP_SA(0, 1), 1, k2);
            GP_WAIT_V(8); GP_WAIT_L(0); GP_BAR; GP_MMA(0, 0, At, B0); GP_MMA(0, 1, At, B1); GP_BAR; GP_SCHED;
            GP_LDA(At, 1, 1); GP_STAGE_B(GP_SB(1, 0), b3_0); GP_STAGE_B(GP_SB(1, 1), b3_1); GP_STAGE_A(GP_SA(1, 0), 0, k2 + kstep);
            GP_WAIT_V(8); GP_WAIT_L(0); GP_BAR; GP_MMA(1, 0, At, B0); GP_MMA(1, 1, At, B1); GP_BAR; GP_SCHED;
        }
        if constexpr (ALIGN_EPI) { if (wr == 0) GP_BAR; }
        { const int l2 = olane(); E(acc, cur, wr, wc, l2 & 15, l2 >> 4); }
        if (!has_next) break;
#pragma unroll
        for (int a = 0; a < 2; ++a)
#pragma unroll
            for (int b = 0; b < 2; ++b)
#pragma unroll
                for (int m = 0; m < 4; ++m)
#pragma unroll
                    for (int n = 0; n < 2; ++n) acc[a][b][m][n] = (f32x4){0.f, 0.f, 0.f, 0.f};
        cur = nxt; ++ui;
        if constexpr (ALIGN_EPI) { if (wr == 1) GP_BAR; }
    }
    GP_WAIT_V(0);
    if constexpr (!ALIGN_EPI) { if (wr == 0) GP_BAR; }
    GP_BAR;
#undef GP_SA
#undef GP_SB
#undef GP_STAGE_A
#undef GP_STAGE_B
#undef GP_LDA
#undef GP_LDB
#undef GP_MMA
#undef GP_WAIT_V
#undef GP_WAIT_L
#undef GP_BAR
#undef GP_SCHED
#undef GP_BPTR
}
}


typedef f32x4 acc_t[2][2][4][2];
struct SchedRect {
    static constexpr bool GATHER = false, ROWIMG = false;
    int G, c, nM, nN, lda, ldb; unsigned Bt;
    __device__ __forceinline__ bool next(int i, gp::Unit& u) const {
        int pm, pn; if (!gp::static_order(i, G, c, nM, nN, pm, pn)) return false;
        u.pm = pm; u.pn = pn; u.b0 = Bt + (unsigned)(pn * 256 * ldb * 2); u.b1 = u.b0 + (unsigned)(128 * ldb * 2); u.bd = 0; u.ks = 1 << 30; u.x0 = 0; u.x1 = 0; return true; }
    __device__ __forceinline__ int a_pitch() const { return lda * 2; }
    __device__ __forceinline__ unsigned a_half(const gp::Unit& u, int h) const { return (unsigned)((u.pm * 256 + h * 128) * lda * 2); }
};
constexpr int TAB_OFF = 131072;
struct MoeTab {
    LAS const int* tab; int total;
    __device__ __forceinline__ void locate(int tg, int& cls, int& x0, int& nvalid) const {
        cls = __builtin_amdgcn_readfirstlane(tab[4 + 4 * tg]); x0 = __builtin_amdgcn_readfirstlane(tab[5 + 4 * tg]); nvalid = __builtin_amdgcn_readfirstlane(tab[6 + 4 * tg]); }
};
__device__ __forceinline__ MoeTab moe_tab_build(LAS unsigned char* lds, const unsigned* cnt) {
    LAS int* tab = (LAS int*)(lds + TAB_OFF);
    const int tg = threadIdx.x;
    if (tg < 192) {
        int base = 0, cls = 0, x0 = 0, nv = 0;
#pragma nounroll
        for (int c = 0; c < NCLS; ++c) { const int n = (int)cnt[64 * c]; const int nt = (n + 255) >> 8;
            if (tg >= base && tg < base + nt) { cls = c; const int tin = tg - base; x0 = c * R + tin * 256; nv = n - tin * 256 < 256 ? n - tin * 256 : 256; }
            base += nt; }
        tab[4 + 4 * tg] = cls; tab[5 + 4 * tg] = x0; tab[6 + 4 * tg] = nv;
        if (tg == 0) tab[0] = base;
    }
    __syncthreads();
    MoeTab t; t.tab = tab; t.total = __builtin_amdgcn_readfirstlane(tab[0]);
    return t;
}
constexpr int ROWC_OFF = 135168;
template <bool F8> struct SchedM1 {
    static constexpr bool GATHER = true, ROWIMG = true;
    int G, c, layer; MoeTab tab; const int* lst; unsigned char* ws;
    static constexpr int EB = F8 ? 1 : 2;
    __device__ __forceinline__ bool next(int i, gp::Unit& u) const {
        int pm, pn; if (!gp::static_order(i, G, c, tab.total, 8, pm, pn)) return false;
        int cls, x0, nv; tab.locate(pm, cls, x0, nv); int elo, ehi; cls_experts(cls, elo, ehi); const int e = pn < 4 ? elo : ehi, pp = pn & 3;
        u.pm = pm; u.pn = pn; u.x0 = x0; u.x1 = nv; u.bd = 0; u.ks = 1 << 30;
        u.b0 = (unsigned)(WS_WEXP + ((size_t)((layer * 16 + e) * 3 + 0)) * MiB) + (unsigned)(pp * 128 * D * EB);
        u.b1 = (unsigned)(WS_WEXP + ((size_t)((layer * 16 + e) * 3 + 1)) * MiB) + (unsigned)(pp * 128 * D * EB); return true; }
    __device__ __forceinline__ void a_rows(const gp::Unit& u, int tid, unsigned (&off)[2][2]) const {
        int Rs[2], Cs[2]; gp::stage_rc(tid * 16, Rs[0], Cs[0]); gp::stage_rc(tid * 16 + 8192, Rs[1], Cs[1]);
#pragma unroll
        for (int h = 0; h < 2; ++h)
#pragma unroll
            for (int i = 0; i < 2; ++i) { const int ri = h * 128 + Rs[i]; int id = lst[u.x0 + (ri < u.x1 ? ri : 0)]; if (ri >= u.x1) id = ZROW; off[h][i] = (unsigned)(id * D * EB + Cs[i] * 2); } }
    __device__ __forceinline__ void rows_prefetch(const gp::Unit& u, __amdgpu_buffer_rsrc_t rs, LAS unsigned char* lds, int par, int wid, int lane) const {
        if (wid == 0) gp::bdma16(rs, (unsigned)lane * 16u, (unsigned)(WS_MISC + MISC_LIST) + (unsigned)u.x0 * 4u, lds + ROWC_OFF + par * 1024); }
    __device__ __forceinline__ void rows_from_lds(const gp::Unit& u, LAS unsigned char* lds, int par, int tid, unsigned (&off)[2][2]) const {
        int Rs[2], Cs[2]; gp::stage_rc(tid * 16, Rs[0], Cs[0]); gp::stage_rc(tid * 16 + 8192, Rs[1], Cs[1]);
        const LAS int* rc = (const LAS int*)(lds + ROWC_OFF + par * 1024);
#pragma unroll
        for (int h = 0; h < 2; ++h)
#pragma unroll
            for (int i = 0; i < 2; ++i) { const int ri = h * 128 + Rs[i]; int id = rc[ri]; if (ri >= u.x1) id = ZROW; off[h][i] = (unsigned)(id * D * EB + Cs[i] * 2); } }
};
template <bool F8> struct SchedM2 {
    static constexpr bool GATHER = false, ROWIMG = true;
    __device__ __forceinline__ void rows_prefetch(const gp::Unit& u, __amdgpu_buffer_rsrc_t rs, LAS unsigned char* lds, int par, int wid, int lane) const {
        if (wid == 0) gp::bdma16(rs, (unsigned)lane * 16u, (unsigned)(WS_MISC + MISC_LIST) + (unsigned)u.x0 * 4u, lds + ROWC_OFF + par * 1024); }
    int G, c, layer; MoeTab tab; unsigned char* ws;
    static constexpr int EB = F8 ? 1 : 2;
    __device__ __forceinline__ bool next(int i, gp::Unit& u) const {
        int pm, pn; if (!gp::static_order(i, G, c, tab.total, 4, pm, pn)) return false;
        int cls, x0, nv; tab.locate(pm, cls, x0, nv); int elo, ehi; cls_experts(cls, elo, ehi);
        u.pm = pm; u.pn = pn; u.x0 = x0; u.x1 = nv; u.ks = F8 ? 4 : 8;
        const unsigned wlo = (unsigned)(WS_WEXP + ((size_t)((layer * 16 + elo) * 3 + 2)) * MiB), whi = (unsigned)(WS_WEXP + ((size_t)((layer * 16 + ehi) * 3 + 2)) * MiB);
        u.b0 = wlo + (unsigned)(pn * 256 * DE * EB); u.b1 = u.b0 + (unsigned)(128 * DE * EB); u.bd = (int)(whi - wlo) - (F8 ? 4 : 8) * 128; return true; }
    __device__ __forceinline__ int a_pitch() const { return D * EB; }
    __device__ __forceinline__ unsigned a_half(const gp::Unit& u, int h) const { return (unsigned)((u.pm * 256 + h * 128) * D * EB); }
};
#ifndef EPI_STORE_MODE
#define EPI_STORE_MODE 0
#endif
__device__ __forceinline__ void st16(void* p, u32x4 v) {
    if (EPI_STORE_MODE == 1) asm volatile("global_store_dwordx4 %0, %1, off sc1\n\ts_nop 1" :: "v"(p), "v"(v) : "memory");
    else *(u32x4*)p = v; }
__device__ __forceinline__ void st8(void* p, u32x2 v) {
    if (EPI_STORE_MODE == 1) asm volatile("global_store_dwordx2 %0, %1, off sc1\n\ts_nop 1" :: "v"(p), "v"(v) : "memory");
    else *(u32x2*)p = v; }
__device__ __forceinline__ u32x4 pack8(f32x4 a, f32x4 b) { return (u32x4){pk2(a[0], a[1]), pk2(a[2], a[3]), pk2(b[0], b[1]), pk2(b[2], b[3])}; }
struct EpiP1 {
    static constexpr bool PERM = true;
    bf16_t* Bb; bf16_t* Zb; const float* rs;
    __device__ __forceinline__ void operator()(const acc_t& acc, const gp::Unit& u, int wr, int wc, int fr, int fq) const {
        const int row0 = u.pm * 256 + wr * 64 + fr;
        if (u.pn < 4) { const int col0 = u.pn * 256 + wc * 32 + 8 * fq;
#pragma unroll
            for (int ai = 0; ai < 2; ++ai)
#pragma unroll
                for (int m = 0; m < 4; ++m) { const int row = row0 + ai * 128 + m * 16; const float s = rs[row];
#pragma unroll
                    for (int bj = 0; bj < 2; ++bj) st16(Bb + (size_t)row * D + col0 + bj * 128, pack8(acc[ai][bj][m][0] * s, acc[ai][bj][m][1] * s)); }
        } else { const int col0 = (u.pn - 4) * 128 + wc * 32 + 8 * fq;
#pragma unroll
            for (int ai = 0; ai < 2; ++ai)
#pragma unroll
                for (int m = 0; m < 4; ++m) { const int row = row0 + ai * 128 + m * 16; const float s = rs[row];
                    st16(Zb + (size_t)row * D + col0, pack8((acc[ai][0][m][0] * s) * (acc[ai][1][m][0] * s), (acc[ai][0][m][1] * s) * (acc[ai][1][m][1] * s))); }
        }
    }
};
struct EpiKVQ {
    static constexpr bool PERM = true;
    unsigned char* ws; const float* rs;
    __device__ __forceinline__ void operator()(const acc_t& acc, const gp::Unit& u, int wr, int wc, int fr, int fq) const {
        bf16_t* O = (bf16_t*)(ws + WS_X + (size_t)(u.pn >> 2) * ROWBUF); const float sc = u.pn >= 8 ? QSCALE : 1.f;
        const int row0 = u.pm * 256 + wr * 64 + fr, col0 = (u.pn & 3) * 256 + wc * 32 + 8 * fq;
#pragma unroll
        for (int ai = 0; ai < 2; ++ai)
#pragma unroll
            for (int m = 0; m < 4; ++m) { const int row = row0 + ai * 128 + m * 16; const f32x4* sp = (const f32x4*)(rs + (size_t)row * 16); const f32x4 s0 = sp[0], s1 = sp[1], s2 = sp[2], s3 = sp[3];
                const float ssum = (((s0.x + s0.y) + (s0.z + s0.w)) + ((s1.x + s1.y) + (s1.z + s1.w))) + (((s2.x + s2.y) + (s2.z + s2.w)) + ((s3.x + s3.y) + (s3.z + s3.w))); const float s = sc / sqrtf(ssum * (1.f / D) + RMS_EPS);
#pragma unroll
                for (int bj = 0; bj < 2; ++bj) st16(O + (size_t)row * D + col0 + bj * 128, pack8(acc[ai][bj][m][0] * s, acc[ai][bj][m][1] * s)); }
    }
};
template <bool F8, bool F8OUT> struct EpiM1 {
    static constexpr bool PERM = true;
    bf16_t* H; const float* rs; const float* tw; LAS unsigned char* lds;
    __device__ __forceinline__ void operator()(const acc_t& acc, const gp::Unit& u, int wr, int wc, int fr, int fq) const {
        const int col0 = u.pn * 128 + wc * 32 + 8 * fq, which = u.pn >= 4 ? 1 : 0;
        int rid[2][4]; float s[2][4], w[2][4];
#pragma unroll
        for (int ai = 0; ai < 2; ++ai)
#pragma unroll
            for (int m = 0; m < 4; ++m) { const int rl = ai * 128 + wr * 64 + m * 16 + fr; const int id = ((const LAS int*)(lds + ROWC_OFF + u.par * 1024))[rl]; rid[ai][m] = rl < u.x1 ? id : -1; }
#pragma unroll
        for (int ai = 0; ai < 2; ++ai)
#pragma unroll
            for (int m = 0; m < 4; ++m) { const bool valid = rid[ai][m] >= 0; const int rsafe = valid ? rid[ai][m] : 0; const float sv = rs[rsafe], wv = tw[2 * rsafe + which];
                s[ai][m] = valid ? sv * (F8 ? 1.f / (SA8 * SW8) : 1.f) : 0.f; w[ai][m] = valid ? wv * (F8OUT ? SH8 : 1.f) : 0.f; }
#pragma unroll
        for (int ai = 0; ai < 2; ++ai)
#pragma unroll
            for (int m = 0; m < 4; ++m) { const int rl = ai * 128 + wr * 64 + m * 16 + fr; const float sv = s[ai][m], wv = w[ai][m];
                f32x4 o[2];
#pragma unroll
                for (int n = 0; n < 2; ++n)
#pragma unroll
                    for (int q = 0; q < 4; ++q) { const float g = acc[ai][0][m][n][q] * sv, uu = acc[ai][1][m][n][q] * sv; o[n][q] = silu(g) * uu * wv; }
                if constexpr (F8OUT) st8((unsigned char*)H + (size_t)(u.pm * 256 + rl) * D + col0, (u32x2){pk4_fp8(o[0][0], o[0][1], o[0][2], o[0][3]), pk4_fp8(o[1][0], o[1][1], o[1][2], o[1][3])});
                else st16(H + (size_t)(u.pm * 256 + rl) * D + col0, pack8(o[0], o[1])); }
    }
};
template <int MODE> struct EpiRes {
    static constexpr bool PERM = true;
    bf16_t* hb; LAS unsigned char* lds; int dry; float* ssq; unsigned char* h8; float ascale; bf16_t* alt;
    __device__ __forceinline__ void operator()(const acc_t& acc, const gp::Unit& u, int wr, int wc, int fr, int fq) const {
        if (dry == 3) return;
        const int col0 = u.pn * 256 + wc * 32 + 8 * fq;
        bf16_t* const dst = dry == 2 ? alt : hb;
        int row[2][4];
#pragma unroll
        for (int ai = 0; ai < 2; ++ai)
#pragma unroll
            for (int m = 0; m < 4; ++m) { const int rl = ai * 128 + wr * 64 + m * 16 + fr;
                if (MODE == 2) { const int id = ((const LAS int*)(lds + ROWC_OFF + u.par * 1024))[rl]; row[ai][m] = rl < u.x1 ? id : -1; } else row[ai][m] = u.pm * 256 + rl; }
#pragma unroll
        for (int ai = 0; ai < 2; ++ai) {
            u32x4 old[4][2];
#pragma unroll
            for (int m = 0; m < 4; ++m)
#pragma unroll
                for (int bj = 0; bj < 2; ++bj) old[m][bj] = dry == 2 ? (u32x4){0u, 0u, 0u, 0u} : *(const u32x4*)(hb + (size_t)(row[ai][m] >= 0 ? row[ai][m] : 0) * D + col0 + bj * 128);
#pragma unroll
            for (int m = 0; m < 4; ++m) { float sq = 0.f;
#pragma unroll
                for (int bj = 0; bj < 2; ++bj) { const u32x4 o = old[m][bj];
                    const f32x4 r0 = (f32x4){bflo(o.x), bfhi(o.x), bflo(o.y), bfhi(o.y)} + acc[ai][bj][m][0] * ascale, r1 = (f32x4){bflo(o.z), bfhi(o.z), bflo(o.w), bfhi(o.w)} + acc[ai][bj][m][1] * ascale;
                    const u32x4 p = pack8(r0, r1);
                    if (row[ai][m] >= 0 && dry != 1) { st16(dst + (size_t)row[ai][m] * D + col0 + bj * 128, p);
                        if (h8) st8(h8 + (size_t)row[ai][m] * D + col0 + bj * 128, (u32x2){pk4_fp8(r0[0] * SA8, r0[1] * SA8, r0[2] * SA8, r0[3] * SA8), pk4_fp8(r1[0] * SA8, r1[1] * SA8, r1[2] * SA8, r1[3] * SA8)}); }
                    if (ssq) {
#pragma unroll
                        for (int q = 0; q < 4; ++q) { const float x0 = bflo(p[q]), x1 = bfhi(p[q]); sq += x0 * x0 + x1 * x1; } } }
                if (ssq) { sq += __shfl_xor(sq, 16); sq += __shfl_xor(sq, 32); if (fq == 0 && row[ai][m] >= 0) ssq[(size_t)row[ai][m] * 16 + u.pn * 4 + wc] = sq; } }
        }
    }
};

__device__ __forceinline__ void meta_load_a(const bf16_t* A, u32x4 (&a)[32], int lane) {
    const u32x4* ap = (const u32x4*)(A + (size_t)(lane & 15) * D) + (lane >> 4);
#pragma unroll
    for (int s = 0; s < 32; ++s) a[s] = ap[4 * s];
}
__device__ __forceinline__ f32x4 meta_dot(const u32x4 (&a)[32], const bf16_t* Bt, int brow, int lane) {
    const u32x4* bp = (const u32x4*)(Bt + (size_t)brow * D) + (lane >> 4);
    f32x4 acc = (f32x4){0.f, 0.f, 0.f, 0.f};
#pragma unroll
    for (int h = 0; h < 2; ++h) { u32x4 b[16];
#pragma unroll
        for (int s = 0; s < 16; ++s) b[s] = bp[4 * (16 * h + s)];
#pragma unroll
        for (int s = 0; s < 16; ++s) acc = __builtin_amdgcn_mfma_f32_16x16x32_bf16(__builtin_bit_cast(bf16x8, a[16 * h + s]), __builtin_bit_cast(bf16x8, b[s]), acc, 0, 0, 0); }
    return acc;
}
__device__ __forceinline__ void p1_meta(Frame& F) {
    if (F.gw >= 128) return;
    const bf16_t* W = F.wsb(WS_WIN); bf16_t* Bb = F.wsb(WS_X); bf16_t* Zb = F.wsb(WS_X + ROWBUF); const float* rs = F.rstd(0);
    u32x4 a[32]; meta_load_a(F.wsb(WS_HB) + (size_t)META0 * D, a, F.ln());
    const int l15 = F.ln() & 15, kq = F.ln() >> 4;
    for (int g = F.gw; g < 128; g += F.ngw) {
        if (g < 64) { const int col = g * 16 + l15; const f32x4 acc = meta_dot(a, W, col, F.ln());
#pragma unroll
            for (int r = 0; r < 4; ++r) { const int row = META0 + 4 * kq + r; Bb[(size_t)row * D + col] = f2bf(acc[r] * rs[row]); }
        } else { const int j = (g - 64) * 16 + l15; const int cr = 1024 + (j >> 7) * 256 + (j & 127);
            const f32x4 ac = meta_dot(a, W, cr, F.ln()), au = meta_dot(a, W, cr + 128, F.ln());
#pragma unroll
            for (int r = 0; r < 4; ++r) { const int row = META0 + 4 * kq + r; const float s = rs[row]; Zb[(size_t)row * D + j] = f2bf((ac[r] * s) * (au[r] * s)); } }
    }
}
__device__ __forceinline__ void p3_meta(Frame& F) {
    if (F.gw >= 64) return;
    const bf16_t* W = F.wsb(WS_WOUT); bf16_t* hb = F.wsb(WS_HB);
    u32x4 a[32]; meta_load_a(F.wsb(WS_X + 2 * ROWBUF) + (size_t)META0 * D, a, F.ln());
    const int l15 = F.ln() & 15, kq = F.ln() >> 4;
    for (int g = F.gw; g < 64; g += F.ngw) { const int col = g * 16 + l15; const f32x4 acc = meta_dot(a, W, col, F.ln());
#pragma unroll
        for (int r = 0; r < 4; ++r) { bf16_t* hp = hb + (size_t)(META0 + 4 * kq + r) * D + col; const float hn = bf2f(*hp) + acc[r]; *hp = f2bf(hn);
            if (FP8_M1_MASK & 1) *(F.ws + WS_HB8 + (size_t)(META0 + 4 * kq + r) * D + col) = (unsigned char)(pk4_fp8(hn * SA8, 0.f, 0.f, 0.f) & 0xffu); } }
}
__device__ __forceinline__ void p8_meta(Frame& F, const float* rstd) {
    { const int i = F.gw * 64 + F.ln(); if (i < 2 * 48 * 128) { const int buf = i / (48 * 128), rem = i % (48 * 128); *(u32x4*)(F.wsb(WS_X + (size_t)buf * ROWBUF) + (size_t)(NTOK0 + rem / 128) * D + (rem % 128) * 8) = (u32x4){0u, 0u, 0u, 0u}; } }
    if (F.gw >= 192) return;
    const bf16_t* W = F.wsb(WS_WKVQ);
    u32x4 a[32]; meta_load_a(F.wsb(WS_HB) + (size_t)META0 * D, a, F.ln());
    const int l15 = F.ln() & 15, kq = F.ln() >> 4;
    for (int g = F.gw; g < 192; g += F.ngw) { const int n = g * 16 + l15; const f32x4 acc = meta_dot(a, W, n, F.ln());
        bf16_t* O = F.wsb(WS_X + (size_t)(n >> 10) * ROWBUF); const float sc = n >= 2048 ? QSCALE : 1.f; const int col = n & 1023;
#pragma unroll
        for (int r = 0; r < 4; ++r) { const int row = META0 + 4 * kq + r; const f32x4* sp = (const f32x4*)(rstd + (size_t)row * 16); const f32x4 s0 = sp[0], s1 = sp[1], s2 = sp[2], s3 = sp[3];
            const float ssum = (((s0.x + s0.y) + (s0.z + s0.w)) + ((s1.x + s1.y) + (s1.z + s1.w))) + (((s2.x + s2.y) + (s2.z + s2.w)) + ((s3.x + s3.y) + (s3.z + s3.w)));
            O[(size_t)row * D + col] = f2bf(acc[r] * sc / sqrtf(ssum * (1.f / D) + RMS_EPS)); } }
}

__device__ __forceinline__ void p1_opt(Frame& F) {
    p1_meta(F);
    SchedRect S{(int)gridDim.x, (int)blockIdx.x, MMAIN / 256, 12, D, D, (unsigned)WS_WIN};
    EpiP1 E{F.wsb(WS_X), F.wsb(WS_X + ROWBUF), F.rstd(0)};
    gp::gemm_phase<EpiP1, SchedRect, 16>(F.lds, F.wave, F.ws, (unsigned)WS_HB, D * 2, S, E);
}
__device__ __forceinline__ void p3_opt(Frame& F) {
    p3_meta(F);
    SchedRect S{(int)gridDim.x, (int)blockIdx.x, MMAIN / 256, 4, D, D, (unsigned)WS_WOUT};
    EpiRes<0> E{F.wsb(WS_HB), F.lds, 0, nullptr, (FP8_M1_MASK & 1) ? F.ws + WS_HB8 : nullptr, 1.f, nullptr};
    gp::gemm_phase<EpiRes<0>, SchedRect, 16>(F.lds, F.wave, F.ws, (unsigned)(WS_X + 2 * ROWBUF), D * 2, S, E);
}
template <bool F8IN, bool F8OUT> __device__ __forceinline__ void m1_run(Frame& F, int layer, const float* rstd, const unsigned* cnt) {
    SchedM1<F8IN> S; S.G = (int)gridDim.x; S.c = (int)blockIdx.x; S.layer = layer; S.tab = moe_tab_build(F.lds, cnt); S.lst = F.list(); S.ws = F.ws;
    EpiM1<F8IN, F8OUT> E{F.wsb(WS_H), rstd, F.tokw(), F.lds};
    gp::gemm_phase<EpiM1<F8IN, F8OUT>, SchedM1<F8IN>, F8IN ? 8 : 16, F8IN>(F.lds, F.wave, F.ws, F8IN ? (unsigned)WS_HB8 : (unsigned)WS_HB, F8IN ? D : D * 2, S, E);
}
template <bool F8> __device__ __forceinline__ void m2_run(Frame& F, int layer, const unsigned* cnt, int dry, float* ssq, unsigned char* h8) {
    SchedM2<F8> S; S.G = (int)gridDim.x; S.c = (int)blockIdx.x; S.layer = layer; S.tab = moe_tab_build(F.lds, cnt); S.ws = F.ws;
    EpiRes<2> E{F.wsb(WS_HB), F.lds, dry, dry ? nullptr : ssq, h8, F8 ? 1.f / (SH8 * SWD8) : 1.f, (bf16_t*)F.out};
    gp::gemm_phase<EpiRes<2>, SchedM2<F8>, F8 ? 8 : 16, F8>(F.lds, F.wave, F.ws, (unsigned)WS_H, F8 ? DE : DE * 2, S, E);
}
__device__ __forceinline__ void p8_opt(Frame& F, const float* rstd) {
    p8_meta(F, rstd);
    SchedRect S{(int)gridDim.x, (int)blockIdx.x, MMAIN / 256, 12, D, D, (unsigned)WS_WKVQ};
    EpiKVQ E{F.ws, rstd};
    gp::gemm_phase<EpiKVQ, SchedRect, 16>(F.lds, F.wave, F.ws, (unsigned)WS_HB, D * 2, S, E);
}
__device__ __forceinline__ void p10_opt(Frame& F, const bf16_t* OA, int dry) {
    SchedRect S{(int)gridDim.x, (int)blockIdx.x, MMAIN / 256, 4, D, D, (unsigned)WS_WO};
    EpiRes<0> E{F.wsb(WS_HB), F.lds, dry, nullptr, (FP8_M1_MASK & 2) && !dry ? F.ws + WS_HB8 : nullptr, 1.f, (bf16_t*)F.out};
    gp::gemm_phase<EpiRes<0>, SchedRect, 16>(F.lds, F.wave, F.ws, (unsigned)(WS_X + 2 * ROWBUF), D * 2, S, E);
}

namespace att {
using s16x4 = __attribute__((ext_vector_type(4))) short;
typedef short v4i16_t __attribute__((ext_vector_type(4)));
constexpr int DM = 1024, NW = 8, QBLK = 32, QB = 256, KVBLK = 64;
#define SBAR() __builtin_amdgcn_sched_barrier(0)
__device__ __forceinline__ void cmask(f32x16& p0, f32x16& p1, int jb, int qrel, int hi) {
    const float NEG = -INFINITY; int kb = 64 * jb + 4 * hi;
#pragma unroll
    for (int r = 0; r < 16; ++r) { int kv = kb + (r & 3) + 8 * (r >> 2); if (kv > qrel) p0[r] = NEG; if (kv + 32 > qrel) p1[r] = NEG; }
}
__device__ __forceinline__ float max3f(float a, float b, float c) { float r; asm("v_max3_f32 %0, %1, %2, %3" : "=v"(r) : "v"(a), "v"(b), "v"(c)); return r; }
__device__ __forceinline__ float max2f(float a, float b) { float r; asm("v_max_f32_e32 %0, %1, %2" : "=v"(r) : "v"(a), "v"(b)); return r; }
__device__ __forceinline__ float fadd_s(float a, float b) { float r; asm("v_add_f32_e32 %0, %1, %2" : "=v"(r) : "v"(a), "v"(b)); return r; }
__device__ __forceinline__ float fsub_s(float a, float b) { float r; asm("v_sub_f32_e32 %0, %1, %2" : "=v"(r) : "v"(a), "v"(b)); return r; }
typedef float f32x2_t __attribute__((ext_vector_type(2))); typedef __bf16 bf16x2_t __attribute__((ext_vector_type(2)));
__device__ __forceinline__ unsigned cvtpk_s(float lo, float hi) { f32x2_t v = {lo, hi}; bf16x2_t b = __builtin_convertvector(v, bf16x2_t); return __builtin_bit_cast(unsigned, b); }
#define WAIT_BAR(N) asm volatile("s_waitcnt vmcnt(" #N ") lgkmcnt(0)\n\ts_barrier" ::: "memory")
__device__ __forceinline__ float rowmax(const f32x16& p0, const f32x16& p1) {
    float a = max3f(p0[0], p0[1], p1[0]), b = max3f(p0[2], p0[3], p1[1]); a = max3f(a, p1[2], p1[3]);
#pragma unroll
    for (int r = 4; r < 16; r += 4) { a = max3f(a, p0[r], p0[r + 1]); b = max3f(b, p0[r + 2], p0[r + 3]); a = max3f(a, p1[r], p1[r + 1]); b = max3f(b, p1[r + 2], p1[r + 3]); }
    const float m = max2f(a, b);
    auto rr = __builtin_amdgcn_permlane32_swap(__float_as_uint(m), __float_as_uint(m), false, false);
    return max2f(__uint_as_float(rr[0]), __uint_as_float(rr[1]));
}
#undef SBAR
#undef WAIT_BAR
}

namespace att2 {
using s16x4 = __attribute__((ext_vector_type(4))) short;
typedef short v4i16_t __attribute__((ext_vector_type(4)));
constexpr int DM = 1024, NW = 8, QBLK = 32, KVBLK = 64;
#define SBAR() __builtin_amdgcn_sched_barrier(0)
constexpr int KSLOT = 8192, NKS = 4, VSLOT = 16384, NVS = 3;
constexpr int LDS_K = 0, LDS_V = NKS * KSLOT, LDS_WS = LDS_V + NVS * VSLOT, LDS_OST = LDS_WS + NW * 64 * 4, LDS_END = LDS_OST + NW * 8192;
__device__ __forceinline__ void glds16(const void* gsrc, unsigned lds_dst) { unsigned keep;
    asm volatile("s_mov_b32 %0, m0\n\ts_mov_b32 m0, %2\n\ts_nop 0\n\tglobal_load_lds_dwordx4 %1, off\n\ts_mov_b32 m0, %0" : "=&s"(keep) : "v"(gsrc), "s"(lds_dst) : "memory"); }
typedef __attribute__((address_space(3))) const char* lds_cptr;
#define WAIT_BAR(N) asm volatile("s_waitcnt vmcnt(" #N ") lgkmcnt(0)\n\ts_barrier" ::: "memory")
using att::max3f; using att::max2f; using att::fadd_s; using att::fsub_s; using att::cvtpk_s; using att::cmask; using att::rowmax;
__device__ __forceinline__ s16x4 vtr(lds_cptr p) { return __builtin_bit_cast(s16x4, __builtin_amdgcn_ds_read_tr16_b64_v4i16((LAS v4i16_t*)p)); }
__device__ __forceinline__ bf16x8 kfrag(lds_cptr kp, int i) { return *(const LAS bf16x8*)(kp + (i >> 1) * 2048 + (i & 1) * 512); }

template <int THRL> __device__ __forceinline__ void attn_pass(int qb, const bf16_t* Qu, const bf16_t* __restrict__ Kmeta, const bf16_t* __restrict__ Kmain, const bf16_t* __restrict__ Vmeta, const bf16_t* __restrict__ Vmain,
                                                              f32x16 (&o)[4], float& l_out, char* shm) {
    int tid = threadIdx.x; asm volatile("" : "+v"(tid));
    const int lane = tid & 63, r32 = lane & 31, hi = lane >> 5; const int wid = __builtin_amdgcn_readfirstlane(tid >> 6);
    const bf16_t* Qw = Qu + (long)(wid * QBLK) * DM;
    const unsigned lds0 = (unsigned)(uintptr_t)shm;
    float* wsf = (float*)(shm + LDS_WS) + wid * 64;
    const long koff = (long)lane * DM + wid * 8, voff = (long)(16 * (wid & 3) + (lane >> 2)) * DM + (wid >> 2) * 32 + (lane & 3) * 8;
    const bf16_t* ksrc = Kmain + koff - (long)KVBLK * DM;
    const bf16_t* vsrc = Vmain + voff - (long)KVBLK * DM;
    const unsigned kdst = lds0 + LDS_K + wid * 1024, vdst = lds0 + LDS_V + wid * 1024;
#define DMA_K(t, slot) glds16(ksrc + (long)(t) * KVBLK * DM, (unsigned)__builtin_amdgcn_readfirstlane(kdst + (slot)))
#define DMA_V(t, slot) do { glds16(vsrc + (long)(t) * KVBLK * DM, (unsigned)__builtin_amdgcn_readfirstlane(vdst + (slot))); glds16(vsrc + (long)(t) * KVBLK * DM + 64, (unsigned)__builtin_amdgcn_readfirstlane(vdst + (slot) + 8192)); } while (0)
    const lds_cptr shm3 = (lds_cptr)shm; const lds_cptr kp0 = shm3 + LDS_K + hi * 1024 + r32 * 16; const lds_cptr vp0 = shm3 + LDS_V + ((lane >> 4) & 1) * 32 + (lane & 3) * 8 + (4 * hi + ((lane & 15) >> 2)) * 64;
    const int NT = 4 * qb + 5;
    glds16(Kmeta + koff, (unsigned)__builtin_amdgcn_readfirstlane(kdst));
    glds16(Vmeta + voff, (unsigned)__builtin_amdgcn_readfirstlane(vdst)); glds16(Vmeta + voff + 64, (unsigned)__builtin_amdgcn_readfirstlane(vdst + 8192));
    DMA_K(1, KSLOT); DMA_K(2, 2 * KSLOT);
    bf16x8 qr[4];
#pragma unroll
    for (int d0 = 0; d0 < 4; ++d0) qr[d0] = *reinterpret_cast<const bf16x8*>(&Qw[(long)r32 * DM + d0 * 16 + hi * 8]);
    float mhat = 0.f, l_reg = 0.f;
#pragma unroll
    for (int d = 0; d < 4; ++d) o[d] = f32x16{};
    f32x16 negm = f32x16{}; asm volatile("" : "+v"(negm));
    const int qrel = wid * QBLK + r32;
#define CMASK(P0, P1, t) do { int jb_ = (t) - (NT - 4); if (jb_ >= 0) cmask(P0, P1, jb_, qrel, hi); } while (0)
    bool resc = false;
#define RESC() do { if (resc) { asm volatile("s_waitcnt lgkmcnt(0)" ::: "memory"); \
      _Pragma("unroll") for (int d_ = 0; d_ < 4; ++d_) _Pragma("unroll") for (int r = 0; r < 16; ++r) o[d_][r] *= wsf[crow(r, hi)]; } } while (0)
    f32x16 pA0, pA1, pB0, pB1;
    int ks_cur = 0, ks_next = KSLOT, ks_prev = 3 * KSLOT;
    int vs_prev = 0, vs_cur = 0, vs_next = VSLOT;
#define ROT() do { ks_prev = ks_cur; ks_cur = ks_next; ks_next = (ks_next == (NKS - 1) * KSLOT) ? 0 : ks_next + KSLOT; vs_prev = vs_cur; vs_cur = vs_next; vs_next = (vs_next == (NVS - 1) * VSLOT) ? 0 : vs_next + VSLOT; } while (0)
    WAIT_BAR(4);
    { const lds_cptr kp = kp0;
#pragma unroll
      for (int d0 = 0; d0 < 4; ++d0) { const bf16x8 b0 = kfrag(kp, 2 * d0), b1 = kfrag(kp, 2 * d0 + 1);
          if (d0 == 0) { pA0 = __builtin_amdgcn_mfma_f32_32x32x16_bf16(b0, qr[0], negm, 0, 0, 0); pA1 = __builtin_amdgcn_mfma_f32_32x32x16_bf16(b1, qr[0], negm, 0, 0, 0); }
          else { pA0 = __builtin_amdgcn_mfma_f32_32x32x16_bf16(b0, qr[d0], pA0, 0, 0, 0); pA1 = __builtin_amdgcn_mfma_f32_32x32x16_bf16(b1, qr[d0], pA1, 0, 0, 0); } } }
    asm volatile("s_nop 15\n\ts_nop 7" : "+v"(pA0), "+v"(pA1));
#pragma unroll
    for (int r = 8; r < 16; ++r) pA0[r] = -INFINITY;
#pragma unroll
    for (int r = 0; r < 16; ++r) pA1[r] = -INFINITY;
    { const float rm = rowmax(pA0, pA1); mhat = fadd_s(mhat, rm);
#pragma unroll
      for (int r = 0; r < 16; ++r) { pA0[r] = fsub_s(pA0[r], rm); pA1[r] = fsub_s(pA1[r], rm); }
#pragma unroll
      for (int r = 0; r < 16; ++r) negm[r] = -mhat;
      asm volatile("" : "+v"(negm));
#pragma unroll
      for (int r = 0; r < 16; ++r) { pA0[r] = __builtin_amdgcn_exp2f(pA0[r]); pA1[r] = __builtin_amdgcn_exp2f(pA1[r]); } }
    DMA_K(3, 3 * KSLOT); DMA_V(1, VSLOT);
    WAIT_BAR(3);
    ROT();
    bf16x8 kf[8]; s16x4 vlo[16], vhi[16]; u32x4 pw0, pw1, pw2, pw3;
    kf[0] = kfrag(kp0 + ks_cur, 0); kf[1] = kfrag(kp0 + ks_cur, 1);
#define PKW(P, B) cvtpk_s(P[B], P[B + 1])
#define PAF(k) __builtin_bit_cast(bf16x8, pw##k)
#define VFR(i) (bf16x8){vlo[i][0], vlo[i][1], vlo[i][2], vlo[i][3], vhi[i][0], vhi[i][1], vhi[i][2], vhi[i][3]}
#define PIN(x) asm volatile("" : "+v"(x))
#define MX3(a, b, c) __builtin_fmaxf(__builtin_fmaxf((a), (b)), (c))
#define EX(v) __builtin_amdgcn_exp2f(v)
#define VIX(j) ((((j) & 3) << 2) + ((j) >> 2))
#define VRD(i) do { vlo[i] = vtr(vp_ + (((i) >> 2) * 4096 + ((i) & 3) * 1024)); vhi[i] = vtr(vp_ + (((i) >> 2) * 4096 + ((i) & 3) * 1024 + 512)); } while (0)
#define KRD(i) do { kf[i] = kfrag(kpc_, i); } while (0)
#define GAPA(i, MF, A0, A1, A2, A3, W0, W1, PW) do { if ((i) + 2 < 8) KRD(((i) + 2) & 7); SBAR(); MF; sacc += A0; sacc += A1; sacc += A2; sacc += A3; PIN(sacc); W0; W1; PIN(PW); SBAR(); } while (0)
#define GAPB(j, PA, X, B) do { if ((j) + 2 < 16) VRD(VIX(((j) + 2) & 15)); SBAR(); o[(j) & 3] = __builtin_amdgcn_mfma_f32_32x32x16_bf16(PA, VFR(VIX(j)), o[(j) & 3], 0, 0, 0); X[B] = EX(X[B]); X[B + 1] = EX(X[B + 1]); PIN(X); SBAR(); } while (0)
#define STEP(C0, C1, P0, P1, t, GK, GV, GL) do { SBAR(); \
    const lds_cptr kpc_ = kp0 + ks_cur; const lds_cptr vp_ = vp0 + vs_prev; \
    float sacc = (P0[0] + P0[1]); \
    GAPA(0, C0 = __builtin_amdgcn_mfma_f32_32x32x16_bf16(kf[0], qr[0], negm, 0, 0, 0), P0[2], P0[3], P0[4], P0[5],     pw0[0] = PKW(P0, 0), pw0[1] = PKW(P0, 2), pw0); \
    GAPA(1, C1 = __builtin_amdgcn_mfma_f32_32x32x16_bf16(kf[1], qr[0], negm, 0, 0, 0), P0[6], P0[7], P0[8], P0[9],     pw0[2] = PKW(P0, 4), pw0[3] = PKW(P0, 6), pw0); \
    GAPA(2, C0 = __builtin_amdgcn_mfma_f32_32x32x16_bf16(kf[2], qr[1], C0, 0, 0, 0),   P0[10], P0[11], P0[12], P0[13], pw1[0] = PKW(P0, 8), pw1[1] = PKW(P0, 10), pw1); \
    GAPA(3, C1 = __builtin_amdgcn_mfma_f32_32x32x16_bf16(kf[3], qr[1], C1, 0, 0, 0),   P0[14], P0[15], P1[0], P1[1],   pw1[2] = PKW(P0, 12), pw1[3] = PKW(P0, 14), pw1); \
    GAPA(4, C0 = __builtin_amdgcn_mfma_f32_32x32x16_bf16(kf[4], qr[2], C0, 0, 0, 0),   P1[2], P1[3], P1[4], P1[5],     pw2[0] = PKW(P1, 0), pw2[1] = PKW(P1, 2), pw2); \
    GAPA(5, C1 = __builtin_amdgcn_mfma_f32_32x32x16_bf16(kf[5], qr[2], C1, 0, 0, 0),   P1[6], P1[7], P1[8], P1[9],     pw2[2] = PKW(P1, 4), pw2[3] = PKW(P1, 6), pw2); \
    GAPA(6, C0 = __builtin_amdgcn_mfma_f32_32x32x16_bf16(kf[6], qr[3], C0, 0, 0, 0),   P1[10], P1[11], P1[12], P1[13], pw3[0] = PKW(P1, 8), pw3[1] = PKW(P1, 10), pw3); \
    GAPA(7, C1 = __builtin_amdgcn_mfma_f32_32x32x16_bf16(kf[7], qr[3], C1, 0, 0, 0),   P1[14], P1[15], 0.f, 0.f,       pw3[2] = PKW(P1, 12), pw3[3] = PKW(P1, 14), pw3); \
    l_reg += sacc; \
    VRD(VIX(0)); VRD(VIX(1)); SBAR(); \
    if (GK) { DMA_K((t) + 3, ks_prev); } if (GV) { DMA_V((t) + 1, vs_next); } \
    CMASK(C0, C1, t); \
    { float a = MX3(C0[0], C0[1], C1[0]), b = MX3(C0[2], C0[3], C1[1]); a = MX3(a, C1[2], C1[3]); \
      _Pragma("unroll") for (int r = 4; r < 16; r += 4) { a = MX3(a, C0[r], C0[r + 1]); b = MX3(b, C0[r + 2], C0[r + 3]); a = MX3(a, C1[r], C1[r + 1]); b = MX3(b, C1[r + 2], C1[r + 3]); } \
      float rm = __builtin_fmaxf(a, b); { auto rr = __builtin_amdgcn_permlane32_swap(__float_as_uint(rm), __float_as_uint(rm), false, false); rm = __builtin_fmaxf(__uint_as_float(rr[0]), __uint_as_float(rr[1])); } \
      resc = false; \
      if (__builtin_expect(__any(rm > (float)THRL), 0)) { const float dl = __builtin_fmaxf(rm, 0.f); mhat += dl; \
        _Pragma("unroll") for (int r = 0; r < 16; ++r) { C0[r] -= dl; C1[r] -= dl; } \
        _Pragma("unroll") for (int r = 0; r < 16; ++r) negm[r] = -mhat; asm volatile("" : "+v"(negm)); \
        const float f = __builtin_amdgcn_exp2f(-dl); l_reg *= f; if (hi == 0) wsf[r32] = f; resc = true; } } \
    SBAR(); \
    GAPB(0, PAF(0), C0, 0);  GAPB(1, PAF(0), C0, 2);  GAPB(2, PAF(0), C0, 4);  GAPB(3, PAF(0), C0, 6); \
    GAPB(4, PAF(1), C0, 8);  GAPB(5, PAF(1), C0, 10); GAPB(6, PAF(1), C0, 12); GAPB(7, PAF(1), C0, 14); \
    GAPB(8, PAF(2), C1, 0);  GAPB(9, PAF(2), C1, 2);  GAPB(10, PAF(2), C1, 4); GAPB(11, PAF(2), C1, 6); \
    if (GL) { kf[0] = kfrag(kp0 + ks_next, 0); kf[1] = kfrag(kp0 + ks_next, 1); SBAR(); } \
    GAPB(12, PAF(3), C1, 8); GAPB(13, PAF(3), C1, 10); GAPB(14, PAF(3), C1, 12); GAPB(15, PAF(3), C1, 14); \
    } while (0)
    int t = 1;
#undef CMASK
#define CMASK(P0, P1, t) do { } while (0)
    for (; t + 5 < NT; t += 2) {
        STEP(pB0, pB1, pA0, pA1, t, true, true, true);     WAIT_BAR(3); RESC(); ROT();
        STEP(pA0, pA1, pB0, pB1, t + 1, true, true, true); WAIT_BAR(3); RESC(); ROT();
    }
#undef CMASK
#define CMASK(P0, P1, t) do { int jb_ = (t) - (NT - 4); if (jb_ >= 0) cmask(P0, P1, jb_, qrel, hi); } while (0)
#define ENDW(tt) do { if ((tt) + 3 < NT) { WAIT_BAR(3); } else if ((tt) + 1 < NT) { WAIT_BAR(2); } else { WAIT_BAR(0); } } while (0)
    for (; t + 1 < NT; t += 2) {
        STEP(pB0, pB1, pA0, pA1, t, (t + 3 < NT), (t + 1 < NT), (t + 1 < NT));         ENDW(t);     RESC(); ROT();
        STEP(pA0, pA1, pB0, pB1, t + 1, (t + 4 < NT), (t + 2 < NT), (t + 2 < NT));     ENDW(t + 1); RESC(); ROT();
    }
    { float sacc = pA0[0] + pA0[1]; _Pragma("unroll") for (int r = 2; r < 16; ++r) sacc += pA0[r]; _Pragma("unroll") for (int r = 0; r < 16; ++r) sacc += pA1[r]; l_reg += sacc;
      pw0 = (u32x4){PKW(pA0, 0), PKW(pA0, 2), PKW(pA0, 4), PKW(pA0, 6)}; pw1 = (u32x4){PKW(pA0, 8), PKW(pA0, 10), PKW(pA0, 12), PKW(pA0, 14)}; pw2 = (u32x4){PKW(pA1, 0), PKW(pA1, 2), PKW(pA1, 4), PKW(pA1, 6)}; pw3 = (u32x4){PKW(pA1, 8), PKW(pA1, 10), PKW(pA1, 12), PKW(pA1, 14)};
      const lds_cptr vp_ = vp0 + vs_prev;
#pragma unroll
      for (int dq = 0; dq < 4; ++dq) {
          VRD(dq * 4 + 0); VRD(dq * 4 + 1); VRD(dq * 4 + 2); VRD(dq * 4 + 3);
          o[dq] = __builtin_amdgcn_mfma_f32_32x32x16_bf16(PAF(0), VFR(dq * 4 + 0), o[dq], 0, 0, 0);
          o[dq] = __builtin_amdgcn_mfma_f32_32x32x16_bf16(PAF(1), VFR(dq * 4 + 1), o[dq], 0, 0, 0);
          o[dq] = __builtin_amdgcn_mfma_f32_32x32x16_bf16(PAF(2), VFR(dq * 4 + 2), o[dq], 0, 0, 0);
          o[dq] = __builtin_amdgcn_mfma_f32_32x32x16_bf16(PAF(3), VFR(dq * 4 + 3), o[dq], 0, 0, 0); } }
#undef PKW
#undef PAF
#undef VFR
#undef PIN
#undef MX3
#undef EX
#undef VIX
#undef VRD
#undef KRD
#undef GAPA
#undef GAPB
#undef STEP
#undef ENDW
#undef DMA_K
#undef DMA_V
#undef CMASK
#undef RESC
#undef ROT
    { auto rr = __builtin_amdgcn_permlane32_swap(__float_as_uint(l_reg), __float_as_uint(l_reg), false, false); l_reg = __uint_as_float(rr[0]) + __uint_as_float(rr[1]); }
    l_out = l_reg;
    asm volatile("s_waitcnt lgkmcnt(0)\n\ts_barrier" ::: "memory");
}
__device__ __forceinline__ void attn_unit(int qb, int b, int h, const bf16_t* Qb, const bf16_t* Kb, const bf16_t* Vb, bf16_t* OA, float lam, char* shm) {
    int tid = threadIdx.x; asm volatile("" : "+v"(tid));
    const int lane = tid & 63, r32 = lane & 31, hi = lane >> 5; const int wid = __builtin_amdgcn_readfirstlane(tid >> 6);
    float* wsf = (float*)(shm + LDS_WS) + wid * 64;
    bf16_t* stg = (bf16_t*)(shm + LDS_OST) + wid * 4096;
    bf16_t* sl = stg + hi * 512 + r32;
    const float* wl = wsf + 32 + 4 * hi;
#define CR(r) (((r) & 3) + 8 * ((r) >> 2))
    const long row0 = (long)b * SEQ + qb * 256;
    f32x16 o[4]; float l_reg;
#pragma unroll 1
    for (int c = 0; c < 2; ++c) {
        const int hc = 2 * h + c;
        attn_pass<8>(qb, Qb + row0 * D + hc * 64, Kb + (long)META0 * D + hc * 64, Kb + (long)b * SEQ * D + hc * 64, Vb + (long)META0 * D + h * 128, Vb + (long)b * SEQ * D + h * 128, o, l_reg, shm);
        if (hi == 0) wsf[32 + r32] = l_reg; asm volatile("s_waitcnt lgkmcnt(0)" ::: "memory");
        if (c == 0) {
#pragma unroll
            for (int r = 0; r < 16; ++r) { const float rl = __builtin_amdgcn_rcpf(wl[CR(r)]);
#pragma unroll
                for (int d = 0; d < 4; ++d) sl[CR(r) * 128 + d * 32] = f2bf(o[d][r] * rl); }
            asm volatile("s_waitcnt lgkmcnt(0)" ::: "memory");
        } else {
            float ps[16];
#pragma unroll
            for (int r = 0; r < 16; ++r) { const float rl = lam * __builtin_amdgcn_rcpf(wl[CR(r)]); float s = 0.f;
#pragma unroll
                for (int d = 0; d < 4; ++d) { const float v = bf2f(sl[CR(r) * 128 + d * 32]) - o[d][r] * rl; o[d][r] = v; s += v * v; }
                ps[r] = s; }
#pragma unroll
            for (int r = 0; r < 16; ++r) { float s = ps[r]; s += __shfl_xor(s, 1); s += __shfl_xor(s, 2); s += __shfl_xor(s, 4); s += __shfl_xor(s, 8); s += __shfl_xor(s, 16); ps[r] = 1.0f / sqrtf(s * (1.f / 128.f) + SUBLN_EPS); }
            asm volatile("s_waitcnt lgkmcnt(0)" ::: "memory");
#pragma unroll
            for (int r = 0; r < 16; ++r) {
#pragma unroll
                for (int d = 0; d < 4; ++d) sl[CR(r) * 128 + d * 32] = f2bf(o[d][r] * ps[r]); }
            asm volatile("s_waitcnt lgkmcnt(0)" ::: "memory");
            int l2 = lane; asm volatile("" : "+v"(l2));
            bf16_t* Ow = OA + (row0 + wid * QBLK + (l2 >> 4)) * D + h * 128 + (l2 & 15) * 8; const bf16_t* sr = stg + (l2 >> 4) * 128 + (l2 & 15) * 8;
#pragma unroll
            for (int i = 0; i < 8; ++i) { const u32x4 v = *(const u32x4*)(sr + i * 512); *(u32x4*)(Ow + (long)i * 4 * D) = v; }
            asm volatile("s_waitcnt lgkmcnt(0)" ::: "memory");
        }
    }
#undef CR
}
#undef SBAR
#undef WAIT_BAR
}
__device__ __forceinline__ void p9_attn2(Frame& F, bf16_t* OA) {
    const bf16_t* Kb = F.wsb(WS_X); const bf16_t* Vb = F.wsb(WS_X + ROWBUF); const bf16_t* Qb = F.wsb(WS_X + 2 * ROWBUF);
    const float lam = lambda_full(F);
    const int G = (int)gridDim.x; const int vcu = (G % 8 == 0) ? ((int)blockIdx.x % 8) * (G / 8) + (int)blockIdx.x / 8 : (int)blockIdx.x;
    for (int p = vcu; p < BATCH * 8 * 2; p += G) {
        const int bh = p >> 1, s = p & 1, b = bh >> 3, h = bh & 7;
#pragma unroll 1
        for (int i = 0; i < 4; ++i) {
            const int qb = s == 0 ? (i == 0 ? 7 : (i == 1 ? 0 : (i == 2 ? 5 : 2))) : (i == 0 ? 6 : (i == 1 ? 1 : (i == 2 ? 4 : 3)));
            att2::attn_unit(qb, b, h, Qb, Kb, Vb, OA, lam, (char*)F.lds);
        }
    }
}

constexpr int NPH = 14;
#ifndef DUP_MASK
#define DUP_MASK 0
#endif
#ifndef MK_PER_PHASE
#define MK_PER_PHASE 0
#endif
#ifndef DUP_MASK
#define DUP_MASK 0
#endif
#ifndef DRY_MODE
#define DRY_MODE 3
#endif
__global__ void __launch_bounds__(NTHR, 2) fwd(Args args) {
    extern __shared__ __attribute__((aligned(16))) unsigned char lds_raw[];
    Frame F;
    F.lds = (LAS unsigned char*)lds_raw;
    F.tid = threadIdx.x; F.wave = __builtin_amdgcn_readfirstlane(F.tid >> 6);
    F.gw = blockIdx.x * NWAVES + F.wave; F.ngw = gridDim.x * NWAVES;
    F.ws = args.ws; F.out = args.out; F.ctl = (unsigned*)(args.ws + WS_CTL);
#pragma unroll
    for (int i = 0; i < 22; ++i) F.in[i] = args.in[i];
    volatile LAS unsigned* MISC = (volatile LAS unsigned*)(F.lds + MISC_OFF);
    if (F.tid < 64) MISC[F.tid] = 0u;
    __syncthreads();
    XcdBarrier bar; bar.bar = F.ctl + CW_BAR; bar.x = 0; bar.st = nullptr;
    if (!MK_PER_PHASE) bar = xcd_barrier_post(F.ctl + CW_BAR, MISC + 8);
    const int lo = args.ph_lo, hi = args.ph_hi;
#define IN(k) (lo <= (k) && (k) < hi)
#define SEAM(k) do { if (IN(k) && IN((k) + 1)) xcd_barrier(bar); } while (0)
    unsigned* cnt0 = F.ctl + CW_CNT0; unsigned* cnt1 = F.ctl + CW_CNT1; float* ssq = (float*)(F.ws + WS_MISC + MISC_SSQ);
    bf16_t* OA = F.wsb(WS_X + 2 * ROWBUF);
    bf16_t* O0 = (bf16_t*)F.out; bf16_t* O1 = (bf16_t*)F.out + (size_t)MMAIN * D;
    const int dry = args.pad;
    if (IN(0)) { p0_prologue(F); } SEAM(0);
    if (IN(1)) { p1_opt(F); } SEAM(1);
    if (IN(2)) { p2_conv(F); } SEAM(2);
    if (IN(3)) { p3_opt(F); } SEAM(3);
    if (IN(4)) { p_router(F, 0, NTOK0, F.rstd(1), cnt0, dry); } SEAM(4);
    if (IN(5)) { m1_run<(FP8_M1_MASK & 1) != 0, (FP8_MASK & 1) != 0>(F, 0, F.rstd(1), cnt0); } SEAM(5);
    if (IN(6)) { m2_run<(FP8_MASK & 1) != 0>(F, 0, cnt0, dry, ssq, nullptr); } SEAM(6);
    if (IN(7)) { p8_opt(F, ssq); } SEAM(7);
    if (IN(8)) { p9_attn2(F, OA); } SEAM(8);
    if (IN(9)) { p10_opt(F, OA, dry); } SEAM(9);
    if (IN(10)) { p_router(F, 1, MMAIN, F.rstd(3), cnt1, dry); } SEAM(10);
    if (IN(11)) { m1_run<(FP8_M1_MASK & 2) != 0, (FP8_MASK & 2) != 0>(F, 1, F.rstd(3), cnt1); } SEAM(11);
    if (IN(12)) { m2_run<(FP8_MASK & 2) != 0>(F, 1, cnt1, dry, nullptr, nullptr); } SEAM(12);
    if (IN(13)) { p_final(F, dry); }
#undef IN
#undef SEAM
}

extern "C" void kernel_launch(void* const* d_in, const int* in_sizes, int n_in, void* d_out, int out_size, void* d_ws, size_t ws_size, hipStream_t stream) {
    static int grid = 0;
    if (grid == 0) {
        int dev = 0, cus = 0;
        if (hipGetDevice(&dev) != hipSuccess || hipDeviceGetAttribute(&cus, hipDeviceAttributeMultiprocessorCount, dev) != hipSuccess) { grid = -1; return; }
        if (hipFuncSetAttribute((const void*)fwd, hipFuncAttributeMaxDynamicSharedMemorySize, LDS_BYTES) != hipSuccess) { fprintf(stderr, "kernel_launch: hipFuncSetAttribute failed\n"); grid = -1; return; }
        int per_cu = 0;
        if (hipOccupancyMaxActiveBlocksPerMultiprocessor(&per_cu, (const void*)fwd, NTHR, LDS_BYTES) != hipSuccess || per_cu < 1) fprintf(stderr, "kernel_launch: occupancy query says %d\n", per_cu);
        (void)hipGetLastError();
        grid = cus;
        if (n_in != 22 || ws_size < WS_END) { fprintf(stderr, "kernel_launch: unexpected n_in %d / ws_size %zu\n", n_in, ws_size); grid = -1; return; }
    }
    if (grid < 0) return;
    (void)hipMemsetAsync((char*)d_ws + WS_CTL, 0, CTL_BYTES, stream);
    Args a{};
    for (int i = 0; i < 22; ++i) a.in[i] = (const float*)d_in[i];
    a.out = (float*)d_out; a.ws = (unsigned char*)d_ws; a.pad = 0;
#if MK_PER_PHASE
    for (int p = 0; p < NPH; ++p) { a.ph_lo = p; a.ph_hi = p + 1; a.li = p;
        if ((DUP_MASK >> p) & 1) { a.pad = DRY_MODE; hipLaunchKernelGGL(fwd, dim3(grid), dim3(NTHR), LDS_BYTES, stream, a); a.pad = 0; }
        hipLaunchKernelGGL(fwd, dim3(grid), dim3(NTHR), LDS_BYTES, stream, a); }
#else
    a.ph_lo = 0; a.ph_hi = NPH; a.li = 0;
    hipLaunchKernelGGL(fwd, dim3(grid), dim3(NTHR), LDS_BYTES, stream, a);
#endif
}
```

```cpp
#include <hip/hip_runtime.h>
#include <cstdio>
#include <cstdint>

#define GAS __attribute__((address_space(1)))
#define LAS __attribute__((address_space(3)))
typedef unsigned short bf16_t;
typedef short bf16x8 __attribute__((ext_vector_type(8)));
typedef float f32x4 __attribute__((ext_vector_type(4)));
typedef float f32x16 __attribute__((ext_vector_type(16)));
typedef unsigned u32x4 __attribute__((ext_vector_type(4)));
typedef unsigned u32x2 __attribute__((ext_vector_type(2)));

constexpr int D = 1024, BATCH = 16, SEQ = 2048, NMETA = 16;
constexpr int MMAIN = BATCH * SEQ;
constexpr int META0 = MMAIN;
constexpr int NTOK0 = MMAIN + NMETA;
constexpr int R = MMAIN + 256;
constexpr int ZROW = NTOK0;
constexpr int NCLS = 24, NEXP = 16, DE = 512;
constexpr float RMS_EPS = 1e-6f, SUBLN_EPS = 1e-5f;
constexpr float LOG2E = 1.4426950408889634f;
constexpr float QSCALE = 0.125f * LOG2E;
constexpr int NWAVES = 8, NTHR = 512;
#ifndef FP8_M1_MASK
#define FP8_M1_MASK 3
#endif
#ifndef FP8_MASK
#define FP8_MASK 3
#endif
constexpr float SA8 = 4.f, SW8 = 64.f, SH8 = 8.f, SWD8 = 32.f;

constexpr size_t MiB = 1u << 20;
constexpr size_t WS_CTL = 0, CTL_BYTES = 1 * MiB;
constexpr size_t WS_WIN = 1 * MiB;
constexpr size_t WS_WOUT = 7 * MiB;
constexpr size_t WS_WKVQ = 9 * MiB;
constexpr size_t WS_WO = 15 * MiB;
constexpr size_t WS_WEXP = 17 * MiB;
constexpr size_t WS_WR = 113 * MiB;
constexpr size_t WS_HMETA = 114 * MiB;
constexpr size_t WS_MISC = 115 * MiB;
constexpr size_t WS_HB = 123 * MiB;
constexpr size_t WS_H = 188 * MiB;
constexpr size_t WS_X = 265 * MiB;
constexpr size_t ROWBUF = (size_t)R * D * 2;
constexpr size_t WS_HB8 = 459 * MiB;
constexpr size_t WS_END = WS_HB8 + (size_t)R * D;
static_assert(WS_END <= 512 * MiB, "workspace");
constexpr size_t MISC_RSTD = 0;
constexpr size_t MISC_TOKW = 1 * MiB;
constexpr size_t MISC_TOKC = 1 * MiB + 512 * 1024;
constexpr size_t MISC_LIST = 2 * MiB;
constexpr size_t MISC_SSQ = 5 * MiB + 512 * 1024;
constexpr int CW_BAR = 4096;
constexpr int CW_CNT0 = 16384, CW_CNT1 = 16384 + 64 * 32;
constexpr int CW_SSQ = 131072;

__device__ __forceinline__ float bf2f(unsigned v) { return __uint_as_float(v << 16); }
__device__ __forceinline__ float bflo(unsigned v) { return __uint_as_float(v << 16); }
__device__ __forceinline__ float bfhi(unsigned v) { return __uint_as_float(v & 0xffff0000u); }
__device__ __forceinline__ unsigned pk2(float lo, float hi) { unsigned r; asm("v_cvt_pk_bf16_f32 %0, %1, %2" : "=v"(r) : "v"(lo), "v"(hi)); return r; }
__device__ __forceinline__ bf16_t f2bf(float f) { return (bf16_t)(pk2(f, 0.f) & 0xffffu); }
__device__ __forceinline__ int olane() { unsigned z = 0u; asm volatile("" : "+v"(z)); return (int)__builtin_amdgcn_mbcnt_hi(~0u, __builtin_amdgcn_mbcnt_lo(~0u, z)); }
__device__ __forceinline__ unsigned pk4_fp8(float a, float b, float c, float d) { int p = __builtin_amdgcn_cvt_pk_fp8_f32(a, b, 0, false); p = __builtin_amdgcn_cvt_pk_fp8_f32(c, d, p, true); return (unsigned)p; }
__device__ __forceinline__ float wave_sum(float v) {
#pragma unroll
    for (int o = 1; o < 64; o <<= 1) v += __shfl_xor(v, o);
    return v;
}
__device__ __forceinline__ float wave_max(float v) {
#pragma unroll
    for (int o = 1; o < 64; o <<= 1) v = fmaxf(v, __shfl_xor(v, o));
    return v;
}
__device__ __forceinline__ int crow(int r, int hi) { return (r & 3) + 8 * (r >> 2) + 4 * hi; }
__host__ __device__ __forceinline__ float lambda_init1() { return 0.8f - 0.6f * 0.7408182206817179f; }

#define XB_TMO      128
#define XB_XCNT(j)  (256  + 64 * (j))
#define XB_XSUB(j)  (1280 + 64 * (j))
#define XB_XGEN(j)  (2304 + 64 * (j))
#define XB_TOP      3328
#define XB_TOPGEN   3392
#define XCD_BAR_WORDS 3456
#define XB_SPIN_CAP (1u << 22)
__device__ __forceinline__ unsigned xb_ld(unsigned* p)              { return __hip_atomic_load(p, __ATOMIC_RELAXED, __HIP_MEMORY_SCOPE_AGENT); }
__device__ __forceinline__ unsigned xb_add(unsigned* p, unsigned v) { return __hip_atomic_fetch_add(p, v, __ATOMIC_RELAXED, __HIP_MEMORY_SCOPE_AGENT); }
__device__ __forceinline__ unsigned xb_xcc_id() { return (unsigned)__builtin_amdgcn_s_getreg((3 << 11) | 20) & 0xFu; }
#define XB_SPIN(cond, bar) do { unsigned _sp = 0; while (cond) { __builtin_amdgcn_s_sleep(1); \
    if ((++_sp & 255u) == 0u) { if (xb_ld(&(bar)[XB_TMO])) break; if (_sp > XB_SPIN_CAP) { atomicAdd(&(bar)[XB_TMO], 1u); break; } } } } while (0)
struct XcdBarrier { unsigned* bar; unsigned x; volatile LAS unsigned* st; };
__device__ __forceinline__ XcdBarrier xcd_barrier_post(unsigned* bar, volatile LAS unsigned* st) {
    XcdBarrier b; b.bar = bar; b.x = xb_xcc_id(); b.st = st;
    if (threadIdx.x == 0) (void)xb_add(&bar[XB_XCNT(b.x)], 1u);
    return b;
}
__device__ __forceinline__ void xcd_barrier_complete(unsigned* bar, unsigned x, unsigned& nloc, unsigned& nx) {
    const unsigned G = gridDim.x * gridDim.y * gridDim.z;
    unsigned sum, cnt, mine, sp = 0u;
    for (;;) {
        sum = 0u; cnt = 0u; mine = 0u;
#pragma unroll
        for (unsigned j = 0; j < 16; ++j) { const unsigned c = xb_ld(&bar[XB_XCNT(j)]); sum += c; cnt += (c > 0u) ? 1u : 0u; mine = (j == x) ? c : mine; }
        if (sum == G) break;
        __builtin_amdgcn_s_sleep(1);
        if ((++sp & 255u) == 0u) { if (xb_ld(&bar[XB_TMO])) break; if (sp > XB_SPIN_CAP) { atomicAdd(&bar[XB_TMO], 1u); break; } }
    }
    nloc = mine > 0u ? mine : 1u; nx = cnt > 0u ? cnt : 1u;
}
__device__ __forceinline__ void xcd_barrier(const XcdBarrier& b) {
    asm volatile("s_waitcnt vmcnt(0)" ::: "memory");
    __syncthreads();
    if (threadIdx.x == 0) {
        unsigned* bar = b.bar;
        __builtin_amdgcn_s_waitcnt(0);
        unsigned nloc = b.st[0], nx = b.st[1];
        if (nloc == 0u) { xcd_barrier_complete(bar, b.x, nloc, nx); b.st[0] = nloc; b.st[1] = nx; }
        const unsigned old = xb_add(&bar[XB_XSUB(b.x)], 1u);
        const unsigned gen = old / nloc;
        if (old + 1u == (gen + 1u) * nloc) {
            __builtin_amdgcn_fence(__ATOMIC_RELEASE, "agent");
            asm volatile("s_waitcnt vmcnt(0)" ::: "memory");
            const unsigned og = xb_add(&bar[XB_TOP], 1u);
            const unsigned tg = og / nx;
            if (og + 1u == (tg + 1u) * nx) xb_add(&bar[XB_TOPGEN], 1u);
            else XB_SPIN(xb_ld(&bar[XB_TOPGEN]) == tg, bar);
            __builtin_amdgcn_fence(__ATOMIC_ACQUIRE, "agent");
            xb_add(&bar[XB_XGEN(b.x)], 1u);
            asm volatile("s_waitcnt vmcnt(0)" ::: "memory");
        } else {
            XB_SPIN(xb_ld(&bar[XB_XGEN(b.x)]) == gen, bar);
            __builtin_amdgcn_fence(__ATOMIC_ACQUIRE, "agent");
            asm volatile("s_waitcnt vmcnt(0)" ::: "memory");
        }
    }
    __syncthreads();
}

constexpr int LDS_BYTES = 163840;
constexpr int MISC_OFF = 163584;
struct Args { const float* in[22]; float* out; unsigned char* ws; int ph_lo, ph_hi, li, pad; };
struct Frame {
    LAS unsigned char* lds;
    unsigned* ctl;
    int tid, wave, gw, ngw;
    __device__ __forceinline__ int ln() const { return olane(); }
    const float* in[22]; float* out; unsigned char* ws;
    __device__ __forceinline__ bf16_t* wsb(size_t off) const { return (bf16_t*)(ws + off); }
    __device__ __forceinline__ float* hrow(int r) const { return r < MMAIN ? out + (size_t)r * D : (float*)(ws + WS_HMETA) + (size_t)(r - MMAIN) * D; }
    __device__ __forceinline__ float* rstd(int i) const { return (float*)(ws + WS_MISC + MISC_RSTD + (size_t)i * 262144); }
    __device__ __forceinline__ float* tokw() const { return (float*)(ws + WS_MISC + MISC_TOKW); }
    __device__ __forceinline__ int* tokc() const { return (int*)(ws + WS_MISC + MISC_TOKC); }
    __device__ __forceinline__ int* list() const { return (int*)(ws + WS_MISC + MISC_LIST); }
    __device__ __forceinline__ bf16_t* wexp(int l, int e, int which) const { return (bf16_t*)(ws + WS_WEXP + ((size_t)((l * 16 + e) * 3 + which)) * MiB); }
};
enum { I_X = 0, I_META, I_ANORM, I_WIN, I_CONV, I_WOUT, I_KVNORM, I_WKV, I_BNORM, I_WQ, I_LAMBDA, I_SUBLN, I_WO, I_FFNNORM, I_RGW, I_RGB, I_REW, I_REB, I_WG, I_WU, I_WD, I_FNORM };

__device__ __forceinline__ int win_row(int n) {
    if (n < 1024) return n;
    if (n < 2048) { const int j = n - 1024; return 1024 + (j >> 7) * 256 + (j & 127); }
    const int j = n - 2048; return 1024 + (j >> 7) * 256 + 128 + (j & 127);
}
struct TrJob { const float* W; const float* gain; bf16_t* WT; int K, N, gmask, row_off, mode, item, f8; float gscale; };
__device__ __forceinline__ TrJob tr_decode(Frame& F, int it) {
    constexpr int IT_EXP = 96 * 256, IT_WIN = 16 * 96, IT_WOUT = 16 * 32, IT_WKV = 16 * 64, IT_WQ = 16 * 32;
    TrJob j; j.gain = nullptr; j.gmask = 1023; j.row_off = 0; j.mode = 0; j.gscale = 1.f; j.f8 = 0; int r = it;
    if (r < IT_EXP) { const int m = r >> 8, l = m / 48, e = (m % 48) / 3, which = m % 3; j.item = r & 255;
        if (which == 2) { j.W = F.in[I_WD] + (size_t)(l * 16 + e) * DE * D; j.K = DE; j.N = D; }
        else { j.W = (which == 0 ? F.in[I_WG] : F.in[I_WU]) + (size_t)(l * 16 + e) * D * DE; j.K = D; j.N = DE; j.gain = F.in[I_FFNNORM] + l * D; }
        j.WT = F.wexp(l, e, which); if (which == 2 ? ((FP8_MASK >> l) & 1) : ((FP8_M1_MASK >> l) & 1)) { j.f8 = 1; j.gscale = which == 2 ? SWD8 : SW8; } return j; }
    r -= IT_EXP;
    if (r < IT_WIN) { j.W = F.in[I_WIN]; j.K = D; j.N = 3 * D; j.gain = F.in[I_ANORM]; j.WT = F.wsb(WS_WIN); j.mode = 1; j.item = r; return j; } r -= IT_WIN;
    if (r < IT_WOUT) { j.W = F.in[I_WOUT]; j.K = D; j.N = D; j.WT = F.wsb(WS_WOUT); j.item = r; return j; } r -= IT_WOUT;
    if (r < IT_WKV) { j.W = F.in[I_WKV]; j.K = D; j.N = 2 * D; j.gain = F.in[I_KVNORM]; j.WT = F.wsb(WS_WKVQ); j.item = r; return j; } r -= IT_WKV;
    if (r < IT_WQ) { j.W = F.in[I_WQ]; j.K = D; j.N = D; j.gain = F.in[I_BNORM]; j.WT = F.wsb(WS_WKVQ); j.row_off = 2 * D; j.item = r; return j; } r -= IT_WQ;
    j.W = F.in[I_WO]; j.K = D; j.N = D; j.gain = F.in[I_SUBLN]; j.gmask = 127; j.gscale = 1.f - lambda_init1(); j.WT = F.wsb(WS_WO); j.item = r; return j;
}
__device__ __forceinline__ void tr_load(const TrJob& j, float (&v)[32], int lane) {
    const int nblk = j.N / 32, kb = j.item / nblk, nb = j.item % nblk;
    const float* src = j.W + (size_t)(64 * kb + (lane >> 5)) * j.N + 32 * nb + (lane & 31);
#pragma unroll
    for (int i = 0; i < 32; ++i) v[i] = src[(size_t)(2 * i) * j.N];
}
__device__ __forceinline__ void tr_to_lds(const float (&v)[32], LAS float* scr, int lane) {
#pragma unroll
    for (int i = 0; i < 32; ++i) scr[(2 * i + (lane >> 5)) * 33 + (lane & 31)] = v[i];
}
__device__ __forceinline__ void tr_store(const TrJob& j, LAS float* scr, int lane) {
    const int nblk = j.N / 32, kb = j.item / nblk, nb = j.item % nblk, k0 = 64 * kb, n0 = 32 * nb;
    const int c = lane & 7;
    float g[8];
#pragma unroll
    for (int i = 0; i < 8; ++i) g[i] = (j.gain ? j.gain[(k0 + 8 * c + i) & j.gmask] : 1.f) * j.gscale;
#pragma unroll
    for (int q = 0; q < 4; ++q) { const int n = (lane >> 3) + 8 * q; const LAS float* s = scr + (8 * c) * 33 + n;
        const int nn = n0 + n; const int drow = (j.mode == 1) ? win_row(nn) : j.row_off + nn;
        if (j.f8) { u32x2 o; o.x = pk4_fp8(s[0 * 33] * g[0], s[1 * 33] * g[1], s[2 * 33] * g[2], s[3 * 33] * g[3]); o.y = pk4_fp8(s[4 * 33] * g[4], s[5 * 33] * g[5], s[6 * 33] * g[6], s[7 * 33] * g[7]);
            *(u32x2*)((unsigned char*)j.WT + (size_t)drow * j.K + k0 + 8 * c) = o; }
        else { u32x4 o; o.x = pk2(s[0 * 33] * g[0], s[1 * 33] * g[1]); o.y = pk2(s[2 * 33] * g[2], s[3 * 33] * g[3]); o.z = pk2(s[4 * 33] * g[4], s[5 * 33] * g[5]); o.w = pk2(s[6 * 33] * g[6], s[7 * 33] * g[7]);
            *(u32x4*)(j.WT + (size_t)drow * j.K + k0 + 8 * c) = o; } }
}
__device__ __forceinline__ void p0_prologue(Frame& F) {
    LAS float* scr = (LAS float*)(F.lds + F.wave * 16384);
    constexpr int NITEMS = 96 * 256 + 16 * 96 + 16 * 32 + 16 * 64 + 16 * 32 + 16 * 32;
    { float v[32]; int it = F.gw; TrJob cur; if (it < NITEMS) { cur = tr_decode(F, it); tr_load(cur, v, F.ln()); }
      while (it < NITEMS) {
          tr_to_lds(v, scr, F.ln());
          const int nx = it + F.ngw; TrJob nj; if (nx < NITEMS) { nj = tr_decode(F, nx); tr_load(nj, v, F.ln()); }
          asm volatile("s_waitcnt lgkmcnt(0)" ::: "memory");
          tr_store(cur, scr, F.ln());
          asm volatile("s_waitcnt lgkmcnt(0)" ::: "memory");
          cur = nj; it = nx; } }
    { u32x4* wrf = (u32x4*)(F.ws + WS_WR);
      for (int idx = F.gw * 64 + F.ln(); idx < 2 * 32 * 2 * 64; idx += F.ngw * 64) { const int l = idx >> 12, s = (idx >> 7) & 31, cb = (idx >> 6) & 1, ln = idx & 63; const int col = cb * 16 + (ln & 15), kq = ln >> 4;
          float w[8];
#pragma unroll
          for (int e = 0; e < 8; ++e) { const int k = 32 * s + 8 * kq + e; float v = 0.f;
              if (col < 20) v = F.in[I_FFNNORM][l * D + k] * ((col < 4) ? F.in[I_RGW][(size_t)(l * D + k) * 4 + col] : F.in[I_REW][(size_t)(l * D + k) * 16 + (col - 4)]);
              w[e] = v; }
          const u32x4 hi = (u32x4){pk2(w[0], w[1]), pk2(w[2], w[3]), pk2(w[4], w[5]), pk2(w[6], w[7])};
          const u32x4 lo = (u32x4){pk2(w[0] - bflo(hi.x), w[1] - bfhi(hi.x)), pk2(w[2] - bflo(hi.y), w[3] - bfhi(hi.y)), pk2(w[4] - bflo(hi.z), w[5] - bfhi(hi.z)), pk2(w[6] - bflo(hi.w), w[7] - bfhi(hi.w))};
          u32x4* dst = wrf + (size_t)l * 8192 + ((s * 2 + cb) * 2) * 64 + ln; dst[0] = hi; dst[64] = lo; } }
    bf16_t* hb = F.wsb(WS_HB); float* rs = F.rstd(0);
    for (int r = F.gw; r < R; r += F.ngw) {
        GAS unsigned long long* o8 = (GAS unsigned long long*)(hb + (size_t)r * D) + F.ln();
        if (r >= NTOK0) {
            if (FP8_M1_MASK) ((GAS u32x4*)(F.ws + WS_HB8 + (size_t)r * D))[F.ln()] = (u32x4){0u, 0u, 0u, 0u};
#pragma unroll
            for (int j = 0; j < 4; ++j) o8[64 * j] = 0ull;
            if (F.ln() == 0) rs[r] = 0.f;
            continue;
        }
        const float* src = r < MMAIN ? F.in[I_X] + (size_t)r * D : F.in[I_META] + (size_t)(r - MMAIN) * D;
        const GAS f32x4* xr = (const GAS f32x4*)src + F.ln();
        f32x4 v[4]; float s = 0.f;
#pragma unroll
        for (int j = 0; j < 4; ++j) { v[j] = xr[64 * j]; s += (v[j].x * v[j].x + v[j].y * v[j].y) + (v[j].z * v[j].z + v[j].w * v[j].w); }
        s = wave_sum(s);
#pragma unroll
        for (int j = 0; j < 4; ++j) o8[64 * j] = (unsigned long long)pk2(v[j].x, v[j].y) | ((unsigned long long)pk2(v[j].z, v[j].w) << 32);
        if (F.ln() == 0) rs[r] = 1.0f / sqrtf(s * (1.f / D) + RMS_EPS);
    }
}

__device__ __forceinline__ void p2_conv(Frame& F) {
    const bf16_t* Bb = F.wsb(WS_X); const bf16_t* Zb = F.wsb(WS_X + ROWBUF); bf16_t* G = F.wsb(WS_X + 2 * ROWBUF); const float* cw = F.in[I_CONV];
    const int tid = F.wave * 64 + F.ln(); const int c8 = (tid & 127) * 8, rsub = tid >> 7;
    float w0[8], w1[8], w2[8];
#pragma unroll
    for (int q = 0; q < 2; ++q) { const f32x4 a = *(const f32x4*)(cw + c8 + 4 * q), b = *(const f32x4*)(cw + D + c8 + 4 * q), c = *(const f32x4*)(cw + 2 * D + c8 + 4 * q);
#pragma unroll
        for (int e = 0; e < 4; ++e) { w0[4 * q + e] = a[e]; w1[4 * q + e] = b[e]; w2[4 * q + e] = c[e]; } }
    const int nblk = R / 8;
    for (int blk = blockIdx.x * 4 + rsub; blk < nblk; blk += gridDim.x * 4) {
        const int r0 = blk * 8;
        if (r0 >= NTOK0) {
#pragma unroll
            for (int i = 0; i < 8; ++i) *(u32x4*)(G + (size_t)(r0 + i) * D + c8) = (u32x4){0u, 0u, 0u, 0u};
            continue; }
        int p1, p2;
        if (r0 < MMAIN) { const int s = r0 & (SEQ - 1); p1 = s >= 1 ? r0 - 1 : META0 + 15; p2 = s >= 2 ? r0 - 2 : META0 + 14; }
        else { p1 = r0 > META0 ? r0 - 1 : -1; p2 = r0 > META0 ? r0 - 2 : -1; }
        u32x4 zm2 = p2 >= 0 ? *(const u32x4*)(Zb + (size_t)p2 * D + c8) : (u32x4){0u, 0u, 0u, 0u};
        u32x4 zm1 = p1 >= 0 ? *(const u32x4*)(Zb + (size_t)p1 * D + c8) : (u32x4){0u, 0u, 0u, 0u};
        u32x4 zr[8], br[8];
#pragma unroll
        for (int i = 0; i < 8; ++i) { zr[i] = *(const u32x4*)(Zb + (size_t)(r0 + i) * D + c8); br[i] = *(const u32x4*)(Bb + (size_t)(r0 + i) * D + c8); }
#pragma unroll
        for (int i = 0; i < 8; ++i) { const u32x4 z0 = zr[i], z1 = i >= 1 ? zr[i - 1] : zm1, z2 = i >= 2 ? zr[i - 2] : (i == 1 ? zm1 : zm2); const u32x4 bv = br[i];
            float g[8];
#pragma unroll
            for (int q = 0; q < 4; ++q) {
                g[2 * q] = bflo(bv[q]) * (w0[2 * q] * bflo(z2[q]) + w1[2 * q] * bflo(z1[q]) + w2[2 * q] * bflo(z0[q]));
                g[2 * q + 1] = bfhi(bv[q]) * (w0[2 * q + 1] * bfhi(z2[q]) + w1[2 * q + 1] * bfhi(z1[q]) + w2[2 * q + 1] * bfhi(z0[q])); }
            *(u32x4*)(G + (size_t)(r0 + i) * D + c8) = (u32x4){pk2(g[0], g[1]), pk2(g[2], g[3]), pk2(g[4], g[5]), pk2(g[6], g[7])}; }
    }
}
__device__ __forceinline__ void cls_experts(int cls, int& elo, int& ehi) { const int g = cls / 6, p = cls % 6; const int lo = p < 3 ? 0 : (p < 5 ? 1 : 2), hi = p < 3 ? p + 1 : (p < 5 ? p - 1 : 3); elo = 4 * g + lo; ehi = 4 * g + hi; }
__device__ __forceinline__ float silu(float g) { return g / (1.f + __expf(-g)); }

constexpr int RT_SCR = 131072, RT_HIST = RT_SCR + 8 * 1536;
__device__ __forceinline__ void p_router(Frame& F, int layer, int ntok, float* rstd_out, unsigned* cnt, bool dry) {
    const u32x4* wrf = (const u32x4*)(F.ws + WS_WR) + (size_t)layer * 8192;
    const float* bg = F.in[I_RGB] + layer * 4; const float* be = F.in[I_REB] + layer * 16;
    float* tw = F.tokw(); int* lst = F.list();
    LAS u32x4* bfr = (LAS u32x4*)F.lds;
    { u32x4 tmp[16];
#pragma unroll
      for (int i = 0; i < 16; ++i) tmp[i] = wrf[F.tid + 512 * i];
#pragma unroll
      for (int i = 0; i < 16; ++i) bfr[F.tid + 512 * i] = tmp[i]; }
    LAS int* hist = (LAS int*)(F.lds + RT_HIST);
    LAS float* scr = (LAS float*)(F.lds + RT_SCR + F.wave * 1536);
    const bf16_t* hb = F.wsb(WS_HB);
    const int ntiles = (ntok + 127) >> 7;
    for (int tile = blockIdx.x; tile < ntiles; tile += gridDim.x) {
        __syncthreads();
        if (F.tid < 64) hist[F.tid] = 0;
        __syncthreads();
        const int row = tile * 128 + F.wave * 16 + (F.ln() & 15); const bool rvalid = row < ntok; const int kq = F.ln() >> 4;
        const u32x4* ap = (const u32x4*)(hb + (size_t)(rvalid ? row : ZROW) * D) + kq;
        u32x4 a[32];
#pragma unroll
        for (int s = 0; s < 32; ++s) a[s] = ap[4 * s];
        f32x4 acc0 = (f32x4){0.f, 0.f, 0.f, 0.f}, acc1 = acc0; float ss = 0.f;
#pragma unroll
        for (int s = 0; s < 32; ++s) {
            const LAS u32x4* bp = bfr + (s * 4) * 64 + F.ln();
            const bf16x8 av = __builtin_bit_cast(bf16x8, a[s]);
            acc0 = __builtin_amdgcn_mfma_f32_16x16x32_bf16(av, __builtin_bit_cast(bf16x8, bp[0]), acc0, 0, 0, 0);
            acc1 = __builtin_amdgcn_mfma_f32_16x16x32_bf16(av, __builtin_bit_cast(bf16x8, bp[128]), acc1, 0, 0, 0);
            acc0 = __builtin_amdgcn_mfma_f32_16x16x32_bf16(av, __builtin_bit_cast(bf16x8, bp[64]), acc0, 0, 0, 0);
            acc1 = __builtin_amdgcn_mfma_f32_16x16x32_bf16(av, __builtin_bit_cast(bf16x8, bp[192]), acc1, 0, 0, 0);
#pragma unroll
            for (int q = 0; q < 4; ++q) { const float x0 = bflo(a[s][q]), x1 = bfhi(a[s][q]); ss += x0 * x0 + x1 * x1; }
        }
        ss += __shfl_xor(ss, 16); ss += __shfl_xor(ss, 32);
#pragma unroll
        for (int r = 0; r < 4; ++r) { scr[(4 * kq + r) * 24 + (F.ln() & 15)] = acc0[r]; if ((F.ln() & 15) < 8) scr[(4 * kq + r) * 24 + 16 + (F.ln() & 15)] = acc1[r]; }
        asm volatile("s_waitcnt lgkmcnt(0)" ::: "memory");
        int cls = 0, slot = 0; float rstd = 0.f, wlo = 0.f, whi = 0.f;
        const bool router_lane = F.ln() < 16 && rvalid;
        if (router_lane) {
            rstd = 1.0f / sqrtf(ss * (1.f / D) + RMS_EPS);
            float dt[20];
#pragma unroll
            for (int q = 0; q < 20; ++q) dt[q] = scr[F.ln() * 24 + q] * rstd;
            float lg[4];
#pragma unroll
            for (int q = 0; q < 4; ++q) lg[q] = dt[q] + bg[q];
            int g = 0; float mg = lg[0];
#pragma unroll
            for (int q = 1; q < 4; ++q) if (lg[q] > mg) { mg = lg[q]; g = q; }
            float den = 0.f;
#pragma unroll
            for (int q = 0; q < 4; ++q) den += __expf(lg[q] - mg);
            const float psel = 1.0f / den;
            float le[4];
#pragma unroll
            for (int q = 0; q < 4; ++q) { const float d0 = dt[4 + q] + be[q], d1 = dt[8 + q] + be[4 + q], d2 = dt[12 + q] + be[8 + q], d3 = dt[16 + q] + be[12 + q];
                le[q] = g == 0 ? d0 : (g == 1 ? d1 : (g == 2 ? d2 : d3)); }
            int i1 = 0; float v1 = le[0];
#pragma unroll
            for (int q = 1; q < 4; ++q) if (le[q] > v1) { v1 = le[q]; i1 = q; }
            int i2 = -1; float v2 = -INFINITY;
#pragma unroll
            for (int q = 0; q < 4; ++q) if (q != i1 && le[q] > v2) { v2 = le[q]; i2 = q; }
            const float e2 = __expf(v2 - v1); const float w1 = psel / (1.f + e2), w2 = psel * e2 / (1.f + e2);
            const int lo = i1 < i2 ? i1 : i2, hi = i1 < i2 ? i2 : i1;
            const int pidx = lo == 0 ? hi - 1 : (lo == 1 ? hi + 1 : 5);
            cls = g * 6 + pidx; wlo = i1 < i2 ? w1 : w2; whi = i1 < i2 ? w2 : w1;
            slot = __hip_atomic_fetch_add((int*)(hist + cls), 1, __ATOMIC_RELAXED, __HIP_MEMORY_SCOPE_WORKGROUP);
        }
        __syncthreads();
        if (F.tid < NCLS && !dry) { const int n = hist[F.tid]; hist[32 + F.tid] = n ? (int)atomicAdd(cnt + 64 * F.tid, (unsigned)n) : 0; }
        __syncthreads();
        if (router_lane && !dry) { const int pos = hist[32 + cls] + slot; lst[(size_t)cls * R + pos] = row; rstd_out[row] = rstd; tw[2 * row] = wlo; tw[2 * row + 1] = whi; }
    }
    __syncthreads();
}
__device__ __forceinline__ void p_rowstat(Frame& F, float* rstd_out) {
    const bf16_t* hb = F.wsb(WS_HB);
    for (int r = F.gw; r < R; r += F.ngw) {
        const u32x4* xr = (const u32x4*)(hb + (size_t)r * D) + F.ln(); const u32x4 a = xr[0], b = xr[64]; float s = 0.f;
#pragma unroll
        for (int q = 0; q < 4; ++q) { s += bflo(a[q]) * bflo(a[q]) + bfhi(a[q]) * bfhi(a[q]); s += bflo(b[q]) * bflo(b[q]) + bfhi(b[q]) * bfhi(b[q]); }
        s = wave_sum(s);
        if (F.ln() == 0) rstd_out[r] = 1.0f / sqrtf(s * (1.f / D) + RMS_EPS);
    }
}
__device__ __forceinline__ float lambda_full(Frame& F) {
    const float* lm = F.in[I_LAMBDA]; const int l = F.ln();
    const float a = wave_sum(lm[l] * lm[64 + l]), b = wave_sum(lm[128 + l] * lm[192 + l]);
    return __expf(a) - __expf(b) + lambda_init1();
}
__device__ __forceinline__ void p_final(Frame& F, bool dry) {
    const bf16_t* hb = F.wsb(WS_HB); const float* gn = F.in[I_FNORM];
    const f32x4 g0 = *(const f32x4*)(gn + 8 * F.ln()), g1 = *(const f32x4*)(gn + 8 * F.ln() + 4), g2 = *(const f32x4*)(gn + 512 + 8 * F.ln()), g3 = *(const f32x4*)(gn + 512 + 8 * F.ln() + 4);
    for (int r = F.gw; r < MMAIN; r += F.ngw) {
        const u32x4* xr = (const u32x4*)(hb + (size_t)r * D) + F.ln(); const u32x4 a = xr[0], b = xr[64];
        f32x4 v0 = (f32x4){bflo(a.x), bfhi(a.x), bflo(a.y), bfhi(a.y)}, v1 = (f32x4){bflo(a.z), bfhi(a.z), bflo(a.w), bfhi(a.w)};
        f32x4 v2 = (f32x4){bflo(b.x), bfhi(b.x), bflo(b.y), bfhi(b.y)}, v3 = (f32x4){bflo(b.z), bfhi(b.z), bflo(b.w), bfhi(b.w)};
        float s = (v0.x * v0.x + v0.y * v0.y) + (v0.z * v0.z + v0.w * v0.w) + (v1.x * v1.x + v1.y * v1.y) + (v1.z * v1.z + v1.w * v1.w)
                + (v2.x * v2.x + v2.y * v2.y) + (v2.z * v2.z + v2.w * v2.w) + (v3.x * v3.x + v3.y * v3.y) + (v3.z * v3.z + v3.w * v3.w);
        s = wave_sum(s); const float rstd = 1.0f / sqrtf(s * (1.f / D) + RMS_EPS);
        if (!dry) { f32x4* o = (f32x4*)(F.out + (size_t)r * D + 8 * F.ln());
            o[0] = v0 * rstd * g0; o[1] = v1 * rstd * g1; o[128] = v2 * rstd * g2; o[129] = v3 * rstd * g3; }
    }
}

#ifndef GP_SKEW_TICKS
#define GP_SKEW_TICKS 0
#endif
namespace gp {
typedef int v4i32 __attribute__((ext_vector_type(4))); typedef int v8i32 __attribute__((ext_vector_type(8)));
constexpr int BM = 256, BK = 64, HALF = 128, HTB = HALF * BK * 2, STAGE_BYTES = 8 * HTB, NXCD = 8, WGM = 4;
__host__ __device__ __forceinline__ int lds_byte(int r, int c) { const int st = (r >> 4) * 2 + (c >> 5), rr = r & 15, cc = c & 31, ob = rr * 64 + cc * 2; return st * 1024 + (ob ^ (((ob >> 9) & 1) << 5)); }
__host__ __device__ __forceinline__ void stage_rc(int b, int& R_, int& C_) { const int st = b / 1024, sb = b % 1024, swz = sb ^ (((sb >> 9) & 1) << 5); R_ = (st >> 1) * 16 + swz / 64; C_ = (st & 1) * 32 + (swz % 64) / 2; }
__host__ __device__ __forceinline__ int perm32(int rho) { const int n = rho >> 4, i = rho & 15; return 8 * (i >> 2) + 4 * n + (i & 3); }

struct Unit {
    unsigned b0, b1;
    int bd; int ks;
    int pm, pn;
    int x0, x1;
    int par;
};
__device__ __forceinline__ bool static_order(int i, int G, int c, int nM, int nN, int& pm, int& pn) {
    const int nwg = nM * nN; const int L = i * G + c; if (L >= nwg) return false;
    int wgid = L; { const int q = nwg / NXCD, r = nwg % NXCD, xcd = wgid % NXCD, off = wgid / NXCD; wgid = (xcd < r ? xcd * (q + 1) : r * (q + 1) + (xcd - r) * q) + off; }
    const int nig = WGM * nN, gid = wgid / nig, fm = gid * WGM, gsz = (nM - fm) < WGM ? (nM - fm) : WGM;
    pm = fm + ((wgid % nig) % gsz); pn = (wgid % nig) / gsz; return true;
}
__device__ __forceinline__ void bdma16(__amdgpu_buffer_rsrc_t rs, unsigned voff, unsigned soff, LAS void* l) { __builtin_amdgcn_raw_ptr_buffer_load_lds(rs, l, 16, (int)voff, (int)soff, 0, 0); }

template <class Epi, class Sched, int NT, bool F8 = false, bool ALIGN_EPI = true>
__device__ __forceinline__ void gemm_phase(LAS unsigned char* lds, int wid_in  , unsigned char* ws, unsigned Aoff  , int ldb_bytes  , Sched& S, const Epi& E) {
    constexpr bool GATHER = Sched::GATHER;
    const __amdgpu_buffer_rsrc_t rsrc = __builtin_amdgcn_make_buffer_rsrc((void*)ws, 0, 0x7fffffff, 0x00020000);
    const int wid = wid_in, wr = wid >> 2, wc = wid & 3; const int lane = olane(), tid = wid * 64 + lane, fr = lane & 15, fq = lane >> 4;
    unsigned voffB[2], voffA[2];
#pragma unroll
    for (int i = 0; i < 2; ++i) { int R_, C_; stage_rc(tid * 16 + i * 8192, R_, C_); const int Rb = Epi::PERM ? ((R_ & ~31) + perm32(R_ & 31)) : R_; voffB[i] = (unsigned)(Rb * ldb_bytes + C_ * 2);
        if constexpr (!GATHER) voffA[i] = (unsigned)(R_ * S.a_pitch() + C_ * 2); }
    const unsigned kstep = (unsigned)(BK * 2);
    const unsigned ldsw = (unsigned)wid * 1024u;
    const int aoff = lds_byte(wr * 64 + fr, fq * 8), boff = lds_byte(wc * 32 + fr, fq * 8);
#define GP_SA(b, h) (((b) * 2 + (h)) * HTB)
#define GP_SB(b, h) ((4 + (b) * 2 + (h)) * HTB)
#define GP_STAGE_B(bufoff, gbase) do { bdma16(rsrc, voffB[0], (gbase), lds + (bufoff) + ldsw); bdma16(rsrc, voffB[1], (gbase), lds + (bufoff) + ldsw + 8192); } while (0)
#define GP_STAGE_A(bufoff, h, koff) do { \
        if constexpr (GATHER) { bdma16(rsrc, co[h][0], Aoff + (koff), lds + (bufoff) + ldsw); bdma16(rsrc, co[h][1], Aoff + (koff), lds + (bufoff) + ldsw + 8192); } \
        else { const unsigned g_ = Aoff + cAu[h] + (koff); bdma16(rsrc, voffA[0], g_, lds + (bufoff) + ldsw); bdma16(rsrc, voffA[1], g_, lds + (bufoff) + ldsw + 8192); } } while (0)
#define GP_LDA(dst, b, h) do { if constexpr (F8) { _Pragma("unroll") for (int m = 0; m < 4; ++m) { const v4i32 lo_ = *(const LAS v4i32*)(lds + GP_SA(b, h) + aoff + m * 2048), hi_ = *(const LAS v4i32*)(lds + GP_SA(b, h) + aoff + m * 2048 + 1024); \
            dst##8[m] = __builtin_shufflevector(lo_, hi_, 0, 1, 2, 3, 4, 5, 6, 7); } } \
        else { _Pragma("unroll") for (int m = 0; m < 4; ++m) _Pragma("unroll") for (int k = 0; k < 2; ++k) dst[m][k] = *(const LAS bf16x8*)(lds + GP_SA(b, h) + aoff + m * 2048 + k * 1024); } } while (0)
#define GP_LDB(dst, b, h) do { if constexpr (F8) { _Pragma("unroll") for (int n = 0; n < 2; ++n) { const v4i32 lo_ = *(const LAS v4i32*)(lds + GP_SB(b, h) + boff + n * 2048), hi_ = *(const LAS v4i32*)(lds + GP_SB(b, h) + boff + n * 2048 + 1024); \
            dst##8[n] = __builtin_shufflevector(lo_, hi_, 0, 1, 2, 3, 4, 5, 6, 7); } } \
        else { _Pragma("unroll") for (int n = 0; n < 2; ++n) _Pragma("unroll") for (int k = 0; k < 2; ++k) dst[n][k] = *(const LAS bf16x8*)(lds + GP_SB(b, h) + boff + n * 2048 + k * 1024); } } while (0)
#define GP_MMA(ai, bj, At, Bt) do { __builtin_amdgcn_s_setprio(1); \
        if constexpr (F8) { _Pragma("unroll") for (int m = 0; m < 4; ++m) _Pragma("unroll") for (int n = 0; n < 2; ++n) \
            acc[ai][bj][m][n] = __builtin_amdgcn_mfma_scale_f32_16x16x128_f8f6f4(Bt##8[n], At##8[m], acc[ai][bj][m][n], 0, 0, 0, 0x7f7f7f7f, 0, 0x7f7f7f7f); } \
        else { _Pragma("unroll") for (int m = 0; m < 4; ++m) _Pragma("unroll") for (int n = 0; n < 2; ++n) _Pragma("unroll") for (int k = 0; k < 2; ++k) \
            acc[ai][bj][m][n] = __builtin_amdgcn_mfma_f32_16x16x32_bf16(Bt[n][k], At[m][k], acc[ai][bj][m][n], 0, 0, 0); } \
        __builtin_amdgcn_s_setprio(0); } while (0)
#define GP_WAIT_V(n) asm volatile("s_waitcnt vmcnt(" #n ")" ::: "memory")
#define GP_WAIT_L(n) asm volatile("s_waitcnt lgkmcnt(" #n ")" ::: "memory")
#define GP_BAR __builtin_amdgcn_s_barrier()
#define GP_SCHED __builtin_amdgcn_sched_barrier(0)
#define GP_BPTR(u, h, t) (((h) ? (u).b1 : (u).b0) + (unsigned)(t) * kstep + (unsigned)(((t) >= (u).ks) ? (u).bd : 0))
    Unit cur, nxt; int ui = 0;
    if (!S.next(0, cur)) return;
    f32x4 acc[2][2][4][2];
#pragma unroll
    for (int a = 0; a < 2; ++a)
#pragma unroll
        for (int b = 0; b < 2; ++b)
#pragma unroll
            for (int m = 0; m < 4; ++m)
#pragma unroll
                for (int n = 0; n < 2; ++n) acc[a][b][m][n] = (f32x4){0.f, 0.f, 0.f, 0.f};
    bf16x8 At[4][2], B0[2][2], B1[2][2]; v8i32 At8[4], B08[2], B18[2];
    unsigned co[2][2];
    unsigned cAu[2];
    if constexpr (GATHER) S.a_rows(cur, tid, co); else { cAu[0] = S.a_half(cur, 0); cAu[1] = S.a_half(cur, 1); }
    if constexpr (Sched::ROWIMG) { cur.par = 1; S.rows_prefetch(cur, rsrc, lds, 1, wid, lane); }
    GP_STAGE_B(GP_SB(0, 0), GP_BPTR(cur, 0, 0)); GP_STAGE_B(GP_SB(0, 1), GP_BPTR(cur, 1, 0)); GP_STAGE_A(GP_SA(0, 0), 0, 0u); GP_STAGE_A(GP_SA(0, 1), 1, 0u);
    if (wr == 1) GP_BAR;
    GP_WAIT_V(2); GP_BAR;
    GP_STAGE_B(GP_SB(1, 0), GP_BPTR(cur, 0, 1)); GP_STAGE_A(GP_SA(1, 0), 0, kstep); GP_STAGE_B(GP_SB(1, 1), GP_BPTR(cur, 1, 1));
    GP_WAIT_V(6); GP_BAR;
    for (;;) {
        const bool has_next = S.next(ui + 1, nxt);
        if (!has_next) nxt = cur;
        if constexpr (Sched::ROWIMG) { nxt.par = ui & 1; if (has_next) S.rows_prefetch(nxt, rsrc, lds, ui & 1, wid, olane()); }
#pragma nounroll
        for (int t = 0; t < NT; t += 2) {
            const bool last = (t == NT - 2);
            if (t == 2) E.prefetch(cur, rsrc, lds, wid, olane());
            unsigned b2_0, b2_1, b3_0, b3_1, k2;
            if (last) { k2 = 0; b2_0 = GP_BPTR(nxt, 0, 0); b2_1 = GP_BPTR(nxt, 1, 0); b3_0 = GP_BPTR(nxt, 0, 1); b3_1 = GP_BPTR(nxt, 1, 1); }
            else { k2 = (unsigned)(t + 2) * kstep; b2_0 = GP_BPTR(cur, 0, t + 2); b2_1 = GP_BPTR(cur, 1, t + 2); b3_0 = GP_BPTR(cur, 0, t + 3); b3_1 = GP_BPTR(cur, 1, t + 3); }
            GP_LDB(B0, 0, 0); GP_LDB(B1, 0, 1); GP_SCHED; GP_LDA(At, 0, 0); GP_STAGE_A(GP_SA(1, 1), 1, (unsigned)(t + 1) * kstep);
            GP_WAIT_V(8); GP_WAIT_L(0); GP_BAR; GP_MMA(0, 0, At, B0); GP_MMA(0, 1, At, B1); GP_BAR; GP_SCHED;
            if (last && has_next) { if constexpr (GATHER) S.rows_from_lds(nxt, lds, ui & 1, wid * 64 + olane(), co); else { cAu[0] = S.a_half(nxt, 0); cAu[1] = S.a_half(nxt, 1); } }
            GP_LDA(At, 0, 1); GP_STAGE_B(GP_SB(0, 0), b2_0); GP_STAGE_B(GP_SB(0, 1), b2_1); GP_STAGE_A(GP_SA(0, 0), 0, k2);
            GP_WAIT_V(8); GP_WAIT_L(0); GP_BAR; GP_MMA(1, 0, At, B0); GP_MMA(1, 1, At, B1); GP_BAR; GP_SCHED;
            GP_LDB(B0, 1, 0); GP_LDB(B1, 1, 1); GP_SCHED; GP_LDA(At, 1, 0); GP_STAGE_A(GP_SA(0, 1), 1, k2);
            GP_WAIT_V(8); GP_WAIT_L(0); GP_BAR; GP_MMA(0, 0, At, B0); GP_MMA(0, 1, At, B1); GP_BAR; GP_SCHED;
            GP_LDA(At, 1, 1); GP_STAGE_B(GP_SB(1, 0), b3_0); GP_STAGE_B(GP_SB(1, 1), b3_1); GP_STAGE_A(GP_SA(1, 0), 0, k2 + kstep);
            GP_WAIT_V(8); GP_WAIT_L(0); GP_BAR; GP_MMA(1, 0, At, B0); GP_MMA(1, 1, At, B1); GP_BAR; GP_SCHED;
        }
        if constexpr (ALIGN_EPI) { if (wr == 0) GP_BAR; }
        { const int l2 = olane(); E(acc, cur, wr, wc, l2 & 15, l2 >> 4); }
        if (!has_next) break;
#pragma unroll
        for (int a = 0; a < 2; ++a)
#pragma unroll
            for (int b = 0; b < 2; ++b)
#pragma unroll
                for (int m = 0; m < 4; ++m)
#pragma unroll
                    for (int n = 0; n < 2; ++n) acc[a][b][m][n] = (f32x4){0.f, 0.f, 0.f, 0.f};
        cur = nxt; ++ui;
        if constexpr (ALIGN_EPI) { if (wr == 1) GP_BAR; }
    }
    GP_WAIT_V(0);
    if constexpr (!ALIGN_EPI) { if (wr == 0) GP_BAR; }
    GP_BAR;
#undef GP_SA
#undef GP_SB
#undef GP_STAGE_A
#undef GP_STAGE_B
#undef GP_LDA
#undef GP_LDB
#undef GP_MMA
#undef GP_WAIT_V
#undef GP_WAIT_L
#undef GP_BAR
#undef GP_SCHED
#undef GP_BPTR
}
}


typedef f32x4 acc_t[2][2][4][2];
struct SchedRect {
    static constexpr bool GATHER = false, ROWIMG = false;
    int G, c, nM, nN, lda, ldb; unsigned Bt;
    __device__ __forceinline__ bool next(int i, gp::Unit& u) const {
        int pm, pn; if (!gp::static_order(i, G, c, nM, nN, pm, pn)) return false;
        u.pm = pm; u.pn = pn; u.b0 = Bt + (unsigned)(pn * 256 * ldb * 2); u.b1 = u.b0 + (unsigned)(128 * ldb * 2); u.bd = 0; u.ks = 1 << 30; u.x0 = 0; u.x1 = 0; return true; }
    __device__ __forceinline__ int a_pitch() const { return lda * 2; }
    __device__ __forceinline__ unsigned a_half(const gp::Unit& u, int h) const { return (unsigned)((u.pm * 256 + h * 128) * lda * 2); }
};
constexpr int TAB_OFF = 131072;
struct MoeTab {
    LAS const int* tab; int total;
    __device__ __forceinline__ void locate(int tg, int& cls, int& x0, int& nvalid) const {
        cls = __builtin_amdgcn_readfirstlane(tab[4 + 4 * tg]); x0 = __builtin_amdgcn_readfirstlane(tab[5 + 4 * tg]); nvalid = __builtin_amdgcn_readfirstlane(tab[6 + 4 * tg]); }
};
__device__ __forceinline__ MoeTab moe_tab_build(LAS unsigned char* lds, const unsigned* cnt) {
    LAS int* tab = (LAS int*)(lds + TAB_OFF);
    const int tg = threadIdx.x;
    if (tg < 192) {
        int base = 0, cls = 0, x0 = 0, nv = 0;
#pragma nounroll
        for (int c = 0; c < NCLS; ++c) { const int n = (int)cnt[64 * c]; const int nt = (n + 255) >> 8;
            if (tg >= base && tg < base + nt) { cls = c; const int tin = tg - base; x0 = c * R + tin * 256; nv = n - tin * 256 < 256 ? n - tin * 256 : 256; }
            base += nt; }
        tab[4 + 4 * tg] = cls; tab[5 + 4 * tg] = x0; tab[6 + 4 * tg] = nv;
        if (tg == 0) tab[0] = base;
    }
    __syncthreads();
    MoeTab t; t.tab = tab; t.total = __builtin_amdgcn_readfirstlane(tab[0]);
    return t;
}
constexpr int ROWC_OFF = 135168;
constexpr int EPI_OFF = 137216;
template <bool F8> struct SchedM1 {
    static constexpr bool GATHER = true, ROWIMG = true;
    int G, c, layer; MoeTab tab; const int* lst; unsigned char* ws;
    static constexpr int EB = F8 ? 1 : 2;
    __device__ __forceinline__ bool next(int i, gp::Unit& u) const {
        int pm, pn; if (!gp::static_order(i, G, c, tab.total, 8, pm, pn)) return false;
        int cls, x0, nv; tab.locate(pm, cls, x0, nv); int elo, ehi; cls_experts(cls, elo, ehi); const int e = pn < 4 ? elo : ehi, pp = pn & 3;
        u.pm = pm; u.pn = pn; u.x0 = x0; u.x1 = nv; u.bd = 0; u.ks = 1 << 30;
        u.b0 = (unsigned)(WS_WEXP + ((size_t)((layer * 16 + e) * 3 + 0)) * MiB) + (unsigned)(pp * 128 * D * EB);
        u.b1 = (unsigned)(WS_WEXP + ((size_t)((layer * 16 + e) * 3 + 1)) * MiB) + (unsigned)(pp * 128 * D * EB); return true; }
    __device__ __forceinline__ void a_rows(const gp::Unit& u, int tid, unsigned (&off)[2][2]) const {
        int Rs[2], Cs[2]; gp::stage_rc(tid * 16, Rs[0], Cs[0]); gp::stage_rc(tid * 16 + 8192, Rs[1], Cs[1]);
#pragma unroll
        for (int h = 0; h < 2; ++h)
#pragma unroll
            for (int i = 0; i < 2; ++i) { const int ri = h * 128 + Rs[i]; int id = lst[u.x0 + (ri < u.x1 ? ri : 0)]; if (ri >= u.x1) id = ZROW; off[h][i] = (unsigned)(id * D * EB + Cs[i] * 2); } }
    __device__ __forceinline__ void rows_prefetch(const gp::Unit& u, __amdgpu_buffer_rsrc_t rs, LAS unsigned char* lds, int par, int wid, int lane) const {
        if (wid == 0) gp::bdma16(rs, (unsigned)lane * 16u, (unsigned)(WS_MISC + MISC_LIST) + (unsigned)u.x0 * 4u, lds + ROWC_OFF + par * 1024); }
    __device__ __forceinline__ void rows_from_lds(const gp::Unit& u, LAS unsigned char* lds, int par, int tid, unsigned (&off)[2][2]) const {
        int Rs[2], Cs[2]; gp::stage_rc(tid * 16, Rs[0], Cs[0]); gp::stage_rc(tid * 16 + 8192, Rs[1], Cs[1]);
        const LAS int* rc = (const LAS int*)(lds + ROWC_OFF + par * 1024);
#pragma unroll
        for (int h = 0; h < 2; ++h)
#pragma unroll
            for (int i = 0; i < 2; ++i) { const int ri = h * 128 + Rs[i]; int id = rc[ri]; if (ri >= u.x1) id = ZROW; off[h][i] = (unsigned)(id * D * EB + Cs[i] * 2); } }
};
template <bool F8> struct SchedM2 {
    static constexpr bool GATHER = false, ROWIMG = true;
    __device__ __forceinline__ void rows_prefetch(const gp::Unit& u, __amdgpu_buffer_rsrc_t rs, LAS unsigned char* lds, int par, int wid, int lane) const {
        if (wid == 0) gp::bdma16(rs, (unsigned)lane * 16u, (unsigned)(WS_MISC + MISC_LIST) + (unsigned)u.x0 * 4u, lds + ROWC_OFF + par * 1024); }
    int G, c, layer; MoeTab tab; unsigned char* ws;
    static constexpr int EB = F8 ? 1 : 2;
    __device__ __forceinline__ bool next(int i, gp::Unit& u) const {
        int pm, pn; if (!gp::static_order(i, G, c, tab.total, 4, pm, pn)) return false;
        int cls, x0, nv; tab.locate(pm, cls, x0, nv); int elo, ehi; cls_experts(cls, elo, ehi);
        u.pm = pm; u.pn = pn; u.x0 = x0; u.x1 = nv; u.ks = F8 ? 4 : 8;
        const unsigned wlo = (unsigned)(WS_WEXP + ((size_t)((layer * 16 + elo) * 3 + 2)) * MiB), whi = (unsigned)(WS_WEXP + ((size_t)((layer * 16 + ehi) * 3 + 2)) * MiB);
        u.b0 = wlo + (unsigned)(pn * 256 * DE * EB); u.b1 = u.b0 + (unsigned)(128 * DE * EB); u.bd = (int)(whi - wlo) - (F8 ? 4 : 8) * 128; return true; }
    __device__ __forceinline__ int a_pitch() const { return D * EB; }
    __device__ __forceinline__ unsigned a_half(const gp::Unit& u, int h) const { return (unsigned)((u.pm * 256 + h * 128) * D * EB); }
};
#ifndef EPI_STORE_MODE
#define EPI_STORE_MODE 0
#endif
__device__ __forceinline__ void st16(void* p, u32x4 v) {
    if (EPI_STORE_MODE == 1) asm volatile("global_store_dwordx4 %0, %1, off sc1\n\ts_nop 1" :: "v"(p), "v"(v) : "memory");
    else *(u32x4*)p = v; }
__device__ __forceinline__ void st8(void* p, u32x2 v) {
    if (EPI_STORE_MODE == 1) asm volatile("global_store_dwordx2 %0, %1, off sc1\n\ts_nop 1" :: "v"(p), "v"(v) : "memory");
    else *(u32x2*)p = v; }
__device__ __forceinline__ u32x4 pack8(f32x4 a, f32x4 b) { return (u32x4){pk2(a[0], a[1]), pk2(a[2], a[3]), pk2(b[0], b[1]), pk2(b[2], b[3])}; }
struct EpiP1 {
    static constexpr bool PERM = true;
    bf16_t* Bb; bf16_t* Zb; const float* rs; LAS unsigned char* lds; unsigned rs_off;
    __device__ __forceinline__ void prefetch(const gp::Unit& u, __amdgpu_buffer_rsrc_t rsrc, LAS unsigned char* l, int wid, int lane) const {
        if (wid == 0) gp::bdma16(rsrc, (unsigned)lane * 16u, rs_off + (unsigned)u.pm * 1024u, l + EPI_OFF); }
    __device__ __forceinline__ void operator()(const acc_t& acc, const gp::Unit& u, int wr, int wc, int fr, int fq) const {
        const int row0 = u.pm * 256 + wr * 64 + fr;
        if (u.pn < 4) { const int col0 = u.pn * 256 + wc * 32 + 8 * fq;
#pragma unroll
            for (int ai = 0; ai < 2; ++ai)
#pragma unroll
                for (int m = 0; m < 4; ++m) { const int row = row0 + ai * 128 + m * 16; const float s = ((const LAS float*)(lds + EPI_OFF))[wr * 64 + fr + ai * 128 + m * 16];
#pragma unroll
                    for (int bj = 0; bj < 2; ++bj) st16(Bb + (size_t)row * D + col0 + bj * 128, pack8(acc[ai][bj][m][0] * s, acc[ai][bj][m][1] * s)); }
        } else { const int col0 = (u.pn - 4) * 128 + wc * 32 + 8 * fq;
#pragma unroll
            for (int ai = 0; ai < 2; ++ai)
#pragma unroll
                for (int m = 0; m < 4; ++m) { const int row = row0 + ai * 128 + m * 16; const float s = ((const LAS float*)(lds + EPI_OFF))[wr * 64 + fr + ai * 128 + m * 16];
                    st16(Zb + (size_t)row * D + col0, pack8((acc[ai][0][m][0] * s) * (acc[ai][1][m][0] * s), (acc[ai][0][m][1] * s) * (acc[ai][1][m][1] * s))); }
        }
    }
};
struct EpiKVQ {
    static constexpr bool PERM = true;
    unsigned char* ws; const float* rs; LAS unsigned char* lds;
    __device__ __forceinline__ void prefetch(const gp::Unit& u, __amdgpu_buffer_rsrc_t rsrc, LAS unsigned char* l, int wid, int lane) const {
        const unsigned so = (unsigned)(WS_MISC + MISC_SSQ) + (unsigned)u.pm * 16384u;
        gp::bdma16(rsrc, (unsigned)lane * 16u, so + (unsigned)wid * 2048u, l + EPI_OFF + wid * 2048); gp::bdma16(rsrc, (unsigned)lane * 16u, so + (unsigned)wid * 2048u + 1024u, l + EPI_OFF + wid * 2048 + 1024); }
    __device__ __forceinline__ void operator()(const acc_t& acc, const gp::Unit& u, int wr, int wc, int fr, int fq) const {
        bf16_t* O = (bf16_t*)(ws + WS_X + (size_t)(u.pn >> 2) * ROWBUF); const float sc = u.pn >= 8 ? QSCALE : 1.f;
        const int row0 = u.pm * 256 + wr * 64 + fr, col0 = (u.pn & 3) * 256 + wc * 32 + 8 * fq;
#pragma unroll
        for (int ai = 0; ai < 2; ++ai)
#pragma unroll
            for (int m = 0; m < 4; ++m) { const int row = row0 + ai * 128 + m * 16; const LAS f32x4* sp = (const LAS f32x4*)(lds + EPI_OFF) + (wr * 64 + fr + ai * 128 + m * 16) * 4; const f32x4 s0 = sp[0], s1 = sp[1], s2 = sp[2], s3 = sp[3];
                const float ssum = (((s0.x + s0.y) + (s0.z + s0.w)) + ((s1.x + s1.y) + (s1.z + s1.w))) + (((s2.x + s2.y) + (s2.z + s2.w)) + ((s3.x + s3.y) + (s3.z + s3.w))); const float s = sc / sqrtf(ssum * (1.f / D) + RMS_EPS);
#pragma unroll
                for (int bj = 0; bj < 2; ++bj) st16(O + (size_t)row * D + col0 + bj * 128, pack8(acc[ai][bj][m][0] * s, acc[ai][bj][m][1] * s)); }
    }
};
template <bool F8, bool F8OUT> struct EpiM1 {
    static constexpr bool PERM = true;
    bf16_t* H; const float* rs; const float* tw; LAS unsigned char* lds;
    __device__ __forceinline__ void prefetch(const gp::Unit&, __amdgpu_buffer_rsrc_t, LAS unsigned char*, int, int) const {}
    __device__ __forceinline__ void operator()(const acc_t& acc, const gp::Unit& u, int wr, int wc, int fr, int fq) const {
        const int col0 = u.pn * 128 + wc * 32 + 8 * fq, which = u.pn >= 4 ? 1 : 0;
        int rid[2][4]; float s[2][4], w[2][4];
#pragma unroll
        for (int ai = 0; ai < 2; ++ai)
#pragma unroll
            for (int m = 0; m < 4; ++m) { const int rl = ai * 128 + wr * 64 + m * 16 + fr; const int id = ((const LAS int*)(lds + ROWC_OFF + u.par * 1024))[rl]; rid[ai][m] = rl < u.x1 ? id : -1; }
#pragma unroll
        for (int ai = 0; ai < 2; ++ai)
#pragma unroll
            for (int m = 0; m < 4; ++m) { const bool valid = rid[ai][m] >= 0; const int rsafe = valid ? rid[ai][m] : 0; const float sv = rs[rsafe], wv = tw[2 * rsafe + which];
                s[ai][m] = valid ? sv * (F8 ? 1.f / (SA8 * SW8) : 1.f) : 0.f; w[ai][m] = valid ? wv * (F8OUT ? SH8 : 1.f) : 0.f; }
#pragma unroll
        for (int ai = 0; ai < 2; ++ai)
#pragma unroll
            for (int m = 0; m < 4; ++m) { const int rl = ai * 128 + wr * 64 + m * 16 + fr; const float sv = s[ai][m], wv = w[ai][m];
                f32x4 o[2];
#pragma unroll
                for (int n = 0; n < 2; ++n)
#pragma unroll
                    for (int q = 0; q < 4; ++q) { const float g = acc[ai][0][m][n][q] * sv, uu = acc[ai][1][m][n][q] * sv; o[n][q] = silu(g) * uu * wv; }
                if constexpr (F8OUT) st8((unsigned char*)H + (size_t)(u.pm * 256 + rl) * D + col0, (u32x2){pk4_fp8(o[0][0], o[0][1], o[0][2], o[0][3]), pk4_fp8(o[1][0], o[1][1], o[1][2], o[1][3])});
                else st16(H + (size_t)(u.pm * 256 + rl) * D + col0, pack8(o[0], o[1])); }
    }
};
template <int MODE> struct EpiRes {
    static constexpr bool PERM = true;
    bf16_t* hb; LAS unsigned char* lds; int dry; float* ssq; unsigned char* h8; float ascale; bf16_t* alt;
    __device__ __forceinline__ void prefetch(const gp::Unit&, __amdgpu_buffer_rsrc_t, LAS unsigned char*, int, int) const {}
    __device__ __forceinline__ void operator()(const acc_t& acc, const gp::Unit& u, int wr, int wc, int fr, int fq) const {
        if (dry == 3) return;
        const int col0 = u.pn * 256 + wc * 32 + 8 * fq;
        bf16_t* const dst = dry == 2 ? alt : hb;
        int row[2][4];
#pragma unroll
        for (int ai = 0; ai < 2; ++ai)
#pragma unroll
            for (int m = 0; m < 4; ++m) { const int rl = ai * 128 + wr * 64 + m * 16 + fr;
                if (MODE == 2) { const int id = ((const LAS int*)(lds + ROWC_OFF + u.par * 1024))[rl]; row[ai][m] = rl < u.x1 ? id : -1; } else row[ai][m] = u.pm * 256 + rl; }
#pragma unroll
        for (int ai = 0; ai < 2; ++ai) {
            u32x4 old[4][2];
#pragma unroll
            for (int m = 0; m < 4; ++m)
#pragma unroll
                for (int bj = 0; bj < 2; ++bj) old[m][bj] = dry == 2 ? (u32x4){0u, 0u, 0u, 0u} : *(const u32x4*)(hb + (size_t)(row[ai][m] >= 0 ? row[ai][m] : 0) * D + col0 + bj * 128);
#pragma unroll
            for (int m = 0; m < 4; ++m) { float sq = 0.f;
#pragma unroll
                for (int bj = 0; bj < 2; ++bj) { const u32x4 o = old[m][bj];
                    const f32x4 r0 = (f32x4){bflo(o.x), bfhi(o.x), bflo(o.y), bfhi(o.y)} + acc[ai][bj][m][0] * ascale, r1 = (f32x4){bflo(o.z), bfhi(o.z), bflo(o.w), bfhi(o.w)} + acc[ai][bj][m][1] * ascale;
                    const u32x4 p = pack8(r0, r1);
                    if (row[ai][m] >= 0 && dry != 1) { st16(dst + (size_t)row[ai][m] * D + col0 + bj * 128, p);
                        if (h8) st8(h8 + (size_t)row[ai][m] * D + col0 + bj * 128, (u32x2){pk4_fp8(r0[0] * SA8, r0[1] * SA8, r0[2] * SA8, r0[3] * SA8), pk4_fp8(r1[0] * SA8, r1[1] * SA8, r1[2] * SA8, r1[3] * SA8)}); }
                    if (ssq) {
#pragma unroll
                        for (int q = 0; q < 4; ++q) { const float x0 = bflo(p[q]), x1 = bfhi(p[q]); sq += x0 * x0 + x1 * x1; } } }
                if (ssq) { sq += __shfl_xor(sq, 16); sq += __shfl_xor(sq, 32); if (fq == 0 && row[ai][m] >= 0) ssq[(size_t)row[ai][m] * 16 + u.pn * 4 + wc] = sq; } }
        }
    }
};

__device__ __forceinline__ void meta_load_a(const bf16_t* A, u32x4 (&a)[32], int lane) {
    const u32x4* ap = (const u32x4*)(A + (size_t)(lane & 15) * D) + (lane >> 4);
#pragma unroll
    for (int s = 0; s < 32; ++s) a[s] = ap[4 * s];
}
__device__ __forceinline__ f32x4 meta_dot(const u32x4 (&a)[32], const bf16_t* Bt, int brow, int lane) {
    const u32x4* bp = (const u32x4*)(Bt + (size_t)brow * D) + (lane >> 4);
    f32x4 acc = (f32x4){0.f, 0.f, 0.f, 0.f};
#pragma unroll
    for (int h = 0; h < 2; ++h) { u32x4 b[16];
#pragma unroll
        for (int s = 0; s < 16; ++s) b[s] = bp[4 * (16 * h + s)];
#pragma unroll
        for (int s = 0; s < 16; ++s) acc = __builtin_amdgcn_mfma_f32_16x16x32_bf16(__builtin_bit_cast(bf16x8, a[16 * h + s]), __builtin_bit_cast(bf16x8, b[s]), acc, 0, 0, 0); }
    return acc;
}
__device__ __forceinline__ void p1_meta(Frame& F) {
    if (F.gw >= 128) return;
    const bf16_t* W = F.wsb(WS_WIN); bf16_t* Bb = F.wsb(WS_X); bf16_t* Zb = F.wsb(WS_X + ROWBUF); const float* rs = F.rstd(0);
    u32x4 a[32]; meta_load_a(F.wsb(WS_HB) + (size_t)META0 * D, a, F.ln());
    const int l15 = F.ln() & 15, kq = F.ln() >> 4;
    for (int g = F.gw; g < 128; g += F.ngw) {
        if (g < 64) { const int col = g * 16 + l15; const f32x4 acc = meta_dot(a, W, col, F.ln());
#pragma unroll
            for (int r = 0; r < 4; ++r) { const int row = META0 + 4 * kq + r; Bb[(size_t)row * D + col] = f2bf(acc[r] * rs[row]); }
        } else { const int j = (g - 64) * 16 + l15; const int cr = 1024 + (j >> 7) * 256 + (j & 127);
            const f32x4 ac = meta_dot(a, W, cr, F.ln()), au = meta_dot(a, W, cr + 128, F.ln());
#pragma unroll
            for (int r = 0; r < 4; ++r) { const int row = META0 + 4 * kq + r; const float s = rs[row]; Zb[(size_t)row * D + j] = f2bf((ac[r] * s) * (au[r] * s)); } }
    }
}
__device__ __forceinline__ void p3_meta(Frame& F) {
    if (F.gw >= 64) return;
    const bf16_t* W = F.wsb(WS_WOUT); bf16_t* hb = F.wsb(WS_HB);
    u32x4 a[32]; meta_load_a(F.wsb(WS_X + 2 * ROWBUF) + (size_t)META0 * D, a, F.ln());
    const int l15 = F.ln() & 15, kq = F.ln() >> 4;
    for (int g = F.gw; g < 64; g += F.ngw) { const int col = g * 16 + l15; const f32x4 acc = meta_dot(a, W, col, F.ln());
#pragma unroll
        for (int r = 0; r < 4; ++r) { bf16_t* hp = hb + (size_t)(META0 + 4 * kq + r) * D + col; const float hn = bf2f(*hp) + acc[r]; *hp = f2bf(hn);
            if (FP8_M1_MASK & 1) *(F.ws + WS_HB8 + (size_t)(META0 + 4 * kq + r) * D + col) = (unsigned char)(pk4_fp8(hn * SA8, 0.f, 0.f, 0.f) & 0xffu); } }
}
__device__ __forceinline__ void p8_meta(Frame& F, const float* rstd) {
    { const int i = F.gw * 64 + F.ln(); if (i < 2 * 48 * 128) { const int buf = i / (48 * 128), rem = i % (48 * 128); *(u32x4*)(F.wsb(WS_X + (size_t)buf * ROWBUF) + (size_t)(NTOK0 + rem / 128) * D + (rem % 128) * 8) = (u32x4){0u, 0u, 0u, 0u}; } }
    if (F.gw >= 192) return;
    const bf16_t* W = F.wsb(WS_WKVQ);
    u32x4 a[32]; meta_load_a(F.wsb(WS_HB) + (size_t)META0 * D, a, F.ln());
    const int l15 = F.ln() & 15, kq = F.ln() >> 4;
    for (int g = F.gw; g < 192; g += F.ngw) { const int n = g * 16 + l15; const f32x4 acc = meta_dot(a, W, n, F.ln());
        bf16_t* O = F.wsb(WS_X + (size_t)(n >> 10) * ROWBUF); const float sc = n >= 2048 ? QSCALE : 1.f; const int col = n & 1023;
#pragma unroll
        for (int r = 0; r < 4; ++r) { const int row = META0 + 4 * kq + r; const f32x4* sp = (const f32x4*)(rstd + (size_t)row * 16); const f32x4 s0 = sp[0], s1 = sp[1], s2 = sp[2], s3 = sp[3];
            const float ssum = (((s0.x + s0.y) + (s0.z + s0.w)) + ((s1.x + s1.y) + (s1.z + s1.w))) + (((s2.x + s2.y) + (s2.z + s2.w)) + ((s3.x + s3.y) + (s3.z + s3.w)));
            O[(size_t)row * D + col] = f2bf(acc[r] * sc / sqrtf(ssum * (1.f / D) + RMS_EPS)); } }
}

__device__ __forceinline__ void p1_opt(Frame& F) {
    p1_meta(F);
    SchedRect S{(int)gridDim.x, (int)blockIdx.x, MMAIN / 256, 12, D, D, (unsigned)WS_WIN};
    EpiP1 E{F.wsb(WS_X), F.wsb(WS_X + ROWBUF), F.rstd(0), F.lds, (unsigned)(WS_MISC + MISC_RSTD)};
    gp::gemm_phase<EpiP1, SchedRect, 16>(F.lds, F.wave, F.ws, (unsigned)WS_HB, D * 2, S, E);
}
__device__ __forceinline__ void p3_opt(Frame& F) {
    p3_meta(F);
    SchedRect S{(int)gridDim.x, (int)blockIdx.x, MMAIN / 256, 4, D, D, (unsigned)WS_WOUT};
    EpiRes<0> E{F.wsb(WS_HB), F.lds, 0, nullptr, (FP8_M1_MASK & 1) ? F.ws + WS_HB8 : nullptr, 1.f, nullptr};
    gp::gemm_phase<EpiRes<0>, SchedRect, 16>(F.lds, F.wave, F.ws, (unsigned)(WS_X + 2 * ROWBUF), D * 2, S, E);
}
template <bool F8IN, bool F8OUT> __device__ __forceinline__ void m1_run(Frame& F, int layer, const float* rstd, const unsigned* cnt) {
    SchedM1<F8IN> S; S.G = (int)gridDim.x; S.c = (int)blockIdx.x; S.layer = layer; S.tab = moe_tab_build(F.lds, cnt); S.lst = F.list(); S.ws = F.ws;
    EpiM1<F8IN, F8OUT> E{F.wsb(WS_H), rstd, F.tokw(), F.lds};
    gp::gemm_phase<EpiM1<F8IN, F8OUT>, SchedM1<F8IN>, F8IN ? 8 : 16, F8IN>(F.lds, F.wave, F.ws, F8IN ? (unsigned)WS_HB8 : (unsigned)WS_HB, F8IN ? D : D * 2, S, E);
}
template <bool F8> __device__ __forceinline__ void m2_run(Frame& F, int layer, const unsigned* cnt, int dry, float* ssq, unsigned char* h8) {
    SchedM2<F8> S; S.G = (int)gridDim.x; S.c = (int)blockIdx.x; S.layer = layer; S.tab = moe_tab_build(F.lds, cnt); S.ws = F.ws;
    EpiRes<2> E{F.wsb(WS_HB), F.lds, dry, dry ? nullptr : ssq, h8, F8 ? 1.f / (SH8 * SWD8) : 1.f, (bf16_t*)F.out};
    gp::gemm_phase<EpiRes<2>, SchedM2<F8>, F8 ? 8 : 16, F8>(F.lds, F.wave, F.ws, (unsigned)WS_H, F8 ? DE : DE * 2, S, E);
}
__device__ __forceinline__ void p8_opt(Frame& F, const float* rstd) {
    p8_meta(F, rstd);
    SchedRect S{(int)gridDim.x, (int)blockIdx.x, MMAIN / 256, 12, D, D, (unsigned)WS_WKVQ};
    EpiKVQ E{F.ws, rstd, F.lds};
    gp::gemm_phase<EpiKVQ, SchedRect, 16>(F.lds, F.wave, F.ws, (unsigned)WS_HB, D * 2, S, E);
}
__device__ __forceinline__ void p10_opt(Frame& F, const bf16_t* OA, int dry) {
    SchedRect S{(int)gridDim.x, (int)blockIdx.x, MMAIN / 256, 4, D, D, (unsigned)WS_WO};
    EpiRes<0> E{F.wsb(WS_HB), F.lds, dry, nullptr, (FP8_M1_MASK & 2) && !dry ? F.ws + WS_HB8 : nullptr, 1.f, (bf16_t*)F.out};
    gp::gemm_phase<EpiRes<0>, SchedRect, 16>(F.lds, F.wave, F.ws, (unsigned)(WS_X + 2 * ROWBUF), D * 2, S, E);
}

namespace att {
using s16x4 = __attribute__((ext_vector_type(4))) short;
typedef short v4i16_t __attribute__((ext_vector_type(4)));
constexpr int DM = 1024, NW = 8, QBLK = 32, QB = 256, KVBLK = 64;
#define SBAR() __builtin_amdgcn_sched_barrier(0)
__device__ __forceinline__ void cmask(f32x16& p0, f32x16& p1, int jb, int qrel, int hi) {
    const float NEG = -INFINITY; int kb = 64 * jb + 4 * hi;
#pragma unroll
    for (int r = 0; r < 16; ++r) { int kv = kb + (r & 3) + 8 * (r >> 2); if (kv > qrel) p0[r] = NEG; if (kv + 32 > qrel) p1[r] = NEG; }
}
__device__ __forceinline__ float max3f(float a, float b, float c) { float r; asm("v_max3_f32 %0, %1, %2, %3" : "=v"(r) : "v"(a), "v"(b), "v"(c)); return r; }
__device__ __forceinline__ float max2f(float a, float b) { float r; asm("v_max_f32_e32 %0, %1, %2" : "=v"(r) : "v"(a), "v"(b)); return r; }
__device__ __forceinline__ float fadd_s(float a, float b) { float r; asm("v_add_f32_e32 %0, %1, %2" : "=v"(r) : "v"(a), "v"(b)); return r; }
__device__ __forceinline__ float fsub_s(float a, float b) { float r; asm("v_sub_f32_e32 %0, %1, %2" : "=v"(r) : "v"(a), "v"(b)); return r; }
typedef float f32x2_t __attribute__((ext_vector_type(2))); typedef __bf16 bf16x2_t __attribute__((ext_vector_type(2)));
__device__ __forceinline__ unsigned cvtpk_s(float lo, float hi) { f32x2_t v = {lo, hi}; bf16x2_t b = __builtin_convertvector(v, bf16x2_t); return __builtin_bit_cast(unsigned, b); }
#define WAIT_BAR(N) asm volatile("s_waitcnt vmcnt(" #N ") lgkmcnt(0)\n\ts_barrier" ::: "memory")
__device__ __forceinline__ float rowmax(const f32x16& p0, const f32x16& p1) {
    float a = max3f(p0[0], p0[1], p1[0]), b = max3f(p0[2], p0[3], p1[1]); a = max3f(a, p1[2], p1[3]);
#pragma unroll
    for (int r = 4; r < 16; r += 4) { a = max3f(a, p0[r], p0[r + 1]); b = max3f(b, p0[r + 2], p0[r + 3]); a = max3f(a, p1[r], p1[r + 1]); b = max3f(b, p1[r + 2], p1[r + 3]); }
    const float m = max2f(a, b);
    auto rr = __builtin_amdgcn_permlane32_swap(__float_as_uint(m), __float_as_uint(m), false, false);
    return max2f(__uint_as_float(rr[0]), __uint_as_float(rr[1]));
}
#undef SBAR
#undef WAIT_BAR
}

namespace att2 {
using s16x4 = __attribute__((ext_vector_type(4))) short;
typedef short v4i16_t __attribute__((ext_vector_type(4)));
constexpr int DM = 1024, NW = 8, QBLK = 32, KVBLK = 64;
#define SBAR() __builtin_amdgcn_sched_barrier(0)
constexpr int KSLOT = 8192, NKS = 4, VSLOT = 16384, NVS = 3;
constexpr int LDS_K = 0, LDS_V = NKS * KSLOT, LDS_WS = LDS_V + NVS * VSLOT, LDS_OST = LDS_WS + NW * 64 * 4, LDS_END = LDS_OST + NW * 8192;
__device__ __forceinline__ void glds16(const void* gsrc, unsigned lds_dst) { unsigned keep;
    asm volatile("s_mov_b32 %0, m0\n\ts_mov_b32 m0, %2\n\ts_nop 0\n\tglobal_load_lds_dwordx4 %1, off\n\ts_mov_b32 m0, %0" : "=&s"(keep) : "v"(gsrc), "s"(lds_dst) : "memory"); }
typedef __attribute__((address_space(3))) const char* lds_cptr;
#define WAIT_BAR(N) asm volatile("s_waitcnt vmcnt(" #N ") lgkmcnt(0)\n\ts_barrier" ::: "memory")
using att::max3f; using att::max2f; using att::fadd_s; using att::fsub_s; using att::cvtpk_s; using att::cmask; using att::rowmax;
__device__ __forceinline__ s16x4 vtr(lds_cptr p) { return __builtin_bit_cast(s16x4, __builtin_amdgcn_ds_read_tr16_b64_v4i16((LAS v4i16_t*)p)); }
__device__ __forceinline__ bf16x8 kfrag(lds_cptr kp, int i) { return *(const LAS bf16x8*)(kp + (i >> 1) * 2048 + (i & 1) * 512); }

template <int THRL> __device__ __forceinline__ void attn_pass(int qb, const bf16_t* Qu, const bf16_t* __restrict__ Kmeta, const bf16_t* __restrict__ Kmain, const bf16_t* __restrict__ Vmeta, const bf16_t* __restrict__ Vmain,
                                                              f32x16 (&o)[4], float& l_out, char* shm) {
    int tid = threadIdx.x; asm volatile("" : "+v"(tid));
    const int lane = tid & 63, r32 = lane & 31, hi = lane >> 5; const int wid = __builtin_amdgcn_readfirstlane(tid >> 6);
    const bf16_t* Qw = Qu + (long)(wid * QBLK) * DM;
    const unsigned lds0 = (unsigned)(uintptr_t)shm;
    float* wsf = (float*)(shm + LDS_WS) + wid * 64;
    const long koff = (long)lane * DM + wid * 8, voff = (long)(16 * (wid & 3) + (lane >> 2)) * DM + (wid >> 2) * 32 + (lane & 3) * 8;
    const bf16_t* ksrc = Kmain + koff - (long)KVBLK * DM;
    const bf16_t* vsrc = Vmain + voff - (long)KVBLK * DM;
    const unsigned kdst = lds0 + LDS_K + wid * 1024, vdst = lds0 + LDS_V + wid * 1024;
#define DMA_K(t, slot) glds16(ksrc + (long)(t) * KVBLK * DM, (unsigned)__builtin_amdgcn_readfirstlane(kdst + (slot)))
#define DMA_V(t, slot) do { glds16(vsrc + (long)(t) * KVBLK * DM, (unsigned)__builtin_amdgcn_readfirstlane(vdst + (slot))); glds16(vsrc + (long)(t) * KVBLK * DM + 64, (unsigned)__builtin_amdgcn_readfirstlane(vdst + (slot) + 8192)); } while (0)
    const lds_cptr shm3 = (lds_cptr)shm; const lds_cptr kp0 = shm3 + LDS_K + hi * 1024 + r32 * 16; const lds_cptr vp0 = shm3 + LDS_V + ((lane >> 4) & 1) * 32 + (lane & 3) * 8 + (4 * hi + ((lane & 15) >> 2)) * 64;
    const int NT = 4 * qb + 5;
    glds16(Kmeta + koff, (unsigned)__builtin_amdgcn_readfirstlane(kdst));
    glds16(Vmeta + voff, (unsigned)__builtin_amdgcn_readfirstlane(vdst)); glds16(Vmeta + voff + 64, (unsigned)__builtin_amdgcn_readfirstlane(vdst + 8192));
    DMA_K(1, KSLOT); DMA_K(2, 2 * KSLOT);
    bf16x8 qr[4];
#pragma unroll
    for (int d0 = 0; d0 < 4; ++d0) qr[d0] = *reinterpret_cast<const bf16x8*>(&Qw[(long)r32 * DM + d0 * 16 + hi * 8]);
    float mhat = 0.f, l_reg = 0.f;
#pragma unroll
    for (int d = 0; d < 4; ++d) o[d] = f32x16{};
    f32x16 negm = f32x16{}; asm volatile("" : "+v"(negm));
    const int qrel = wid * QBLK + r32;
#define CMASK(P0, P1, t) do { int jb_ = (t) - (NT - 4); if (jb_ >= 0) cmask(P0, P1, jb_, qrel, hi); } while (0)
    bool resc = false;
#define RESC() do { if (resc) { asm volatile("s_waitcnt lgkmcnt(0)" ::: "memory"); \
      _Pragma("unroll") for (int d_ = 0; d_ < 4; ++d_) _Pragma("unroll") for (int r = 0; r < 16; ++r) o[d_][r] *= wsf[crow(r, hi)]; } } while (0)
    f32x16 pA0, pA1, pB0, pB1;
    int ks_cur = 0, ks_next = KSLOT, ks_prev = 3 * KSLOT;
    int vs_prev = 0, vs_cur = 0, vs_next = VSLOT;
#define ROT() do { ks_prev = ks_cur; ks_cur = ks_next; ks_next = (ks_next == (NKS - 1) * KSLOT) ? 0 : ks_next + KSLOT; vs_prev = vs_cur; vs_cur = vs_next; vs_next = (vs_next == (NVS - 1) * VSLOT) ? 0 : vs_next + VSLOT; } while (0)
    WAIT_BAR(4);
    { const lds_cptr kp = kp0;
#pragma unroll
      for (int d0 = 0; d0 < 4; ++d0) { const bf16x8 b0 = kfrag(kp, 2 * d0), b1 = kfrag(kp, 2 * d0 + 1);
          if (d0 == 0) { pA0 = __builtin_amdgcn_mfma_f32_32x32x16_bf16(b0, qr[0], negm, 0, 0, 0); pA1 = __builtin_amdgcn_mfma_f32_32x32x16_bf16(b1, qr[0], negm, 0, 0, 0); }
          else { pA0 = __builtin_amdgcn_mfma_f32_32x32x16_bf16(b0, qr[d0], pA0, 0, 0, 0); pA1 = __builtin_amdgcn_mfma_f32_32x32x16_bf16(b1, qr[d0], pA1, 0, 0, 0); } } }
    asm volatile("s_nop 15\n\ts_nop 7" : "+v"(pA0), "+v"(pA1));
#pragma unroll
    for (int r = 8; r < 16; ++r) pA0[r] = -INFINITY;
#pragma unroll
    for (int r = 0; r < 16; ++r) pA1[r] = -INFINITY;
    { const float rm = rowmax(pA0, pA1); mhat = fadd_s(mhat, rm);
#pragma unroll
      for (int r = 0; r < 16; ++r) { pA0[r] = fsub_s(pA0[r], rm); pA1[r] = fsub_s(pA1[r], rm); }
#pragma unroll
      for (int r = 0; r < 16; ++r) negm[r] = -mhat;
      asm volatile("" : "+v"(negm));
#pragma unroll
      for (int r = 0; r < 16; ++r) { pA0[r] = __builtin_amdgcn_exp2f(pA0[r]); pA1[r] = __builtin_amdgcn_exp2f(pA1[r]); } }
    DMA_K(3, 3 * KSLOT); DMA_V(1, VSLOT);
    WAIT_BAR(3);
    ROT();
    bf16x8 kf[8]; s16x4 vlo[16], vhi[16]; u32x4 pw0, pw1, pw2, pw3;
    kf[0] = kfrag(kp0 + ks_cur, 0); kf[1] = kfrag(kp0 + ks_cur, 1);
#define PKW(P, B) cvtpk_s(P[B], P[B + 1])
#define PAF(k) __builtin_bit_cast(bf16x8, pw##k)
#define VFR(i) (bf16x8){vlo[i][0], vlo[i][1], vlo[i][2], vlo[i][3], vhi[i][0], vhi[i][1], vhi[i][2], vhi[i][3]}
#define PIN(x) asm volatile("" : "+v"(x))
#define MX3(a, b, c) __builtin_fmaxf(__builtin_fmaxf((a), (b)), (c))
#define EX(v) __builtin_amdgcn_exp2f(v)
#define VIX(j) ((((j) & 3) << 2) + ((j) >> 2))
#define VRD(i) do { vlo[i] = vtr(vp_ + (((i) >> 2) * 4096 + ((i) & 3) * 1024)); vhi[i] = vtr(vp_ + (((i) >> 2) * 4096 + ((i) & 3) * 1024 + 512)); } while (0)
#define KRD(i) do { kf[i] = kfrag(kpc_, i); } while (0)
#define GAPA(i, MF, A0, A1, A2, A3, W0, W1, PW) do { if ((i) + 2 < 8) KRD(((i) + 2) & 7); SBAR(); MF; sacc += A0; sacc += A1; sacc += A2; sacc += A3; PIN(sacc); W0; W1; PIN(PW); SBAR(); } while (0)
#define GAPB(j, PA, X, B) do { if ((j) + 2 < 16) VRD(VIX(((j) + 2) & 15)); SBAR(); o[(j) & 3] = __builtin_amdgcn_mfma_f32_32x32x16_bf16(PA, VFR(VIX(j)), o[(j) & 3], 0, 0, 0); X[B] = EX(X[B]); X[B + 1] = EX(X[B + 1]); PIN(X); SBAR(); } while (0)
#define STEP(C0, C1, P0, P1, t, GK, GV, GL) do { SBAR(); \
    const lds_cptr kpc_ = kp0 + ks_cur; const lds_cptr vp_ = vp0 + vs_prev; \
    float sacc = (P0[0] + P0[1]); \
    GAPA(0, C0 = __builtin_amdgcn_mfma_f32_32x32x16_bf16(kf[0], qr[0], negm, 0, 0, 0), P0[2], P0[3], P0[4], P0[5],     pw0[0] = PKW(P0, 0), pw0[1] = PKW(P0, 2), pw0); \
    GAPA(1, C1 = __builtin_amdgcn_mfma_f32_32x32x16_bf16(kf[1], qr[0], negm, 0, 0, 0), P0[6], P0[7], P0[8], P0[9],     pw0[2] = PKW(P0, 4), pw0[3] = PKW(P0, 6), pw0); \
    GAPA(2, C0 = __builtin_amdgcn_mfma_f32_32x32x16_bf16(kf[2], qr[1], C0, 0, 0, 0),   P0[10], P0[11], P0[12], P0[13], pw1[0] = PKW(P0, 8), pw1[1] = PKW(P0, 10), pw1); \
    GAPA(3, C1 = __builtin_amdgcn_mfma_f32_32x32x16_bf16(kf[3], qr[1], C1, 0, 0, 0),   P0[14], P0[15], P1[0], P1[1],   pw1[2] = PKW(P0, 12), pw1[3] = PKW(P0, 14), pw1); \
    GAPA(4, C0 = __builtin_amdgcn_mfma_f32_32x32x16_bf16(kf[4], qr[2], C0, 0, 0, 0),   P1[2], P1[3], P1[4], P1[5],     pw2[0] = PKW(P1, 0), pw2[1] = PKW(P1, 2), pw2); \
    GAPA(5, C1 = __builtin_amdgcn_mfma_f32_32x32x16_bf16(kf[5], qr[2], C1, 0, 0, 0),   P1[6], P1[7], P1[8], P1[9],     pw2[2] = PKW(P1, 4), pw2[3] = PKW(P1, 6), pw2); \
    GAPA(6, C0 = __builtin_amdgcn_mfma_f32_32x32x16_bf16(kf[6], qr[3], C0, 0, 0, 0),   P1[10], P1[11], P1[12], P1[13], pw3[0] = PKW(P1, 8), pw3[1] = PKW(P1, 10), pw3); \
    GAPA(7, C1 = __builtin_amdgcn_mfma_f32_32x32x16_bf16(kf[7], qr[3], C1, 0, 0, 0),   P1[14], P1[15], 0.f, 0.f,       pw3[2] = PKW(P1, 12), pw3[3] = PKW(P1, 14), pw3); \
    l_reg += sacc; \
    VRD(VIX(0)); VRD(VIX(1)); SBAR(); \
    if (GK) { DMA_K((t) + 3, ks_prev); } if (GV) { DMA_V((t) + 1, vs_next); } \
    CMASK(C0, C1, t); \
    { float a = MX3(C0[0], C0[1], C1[0]), b = MX3(C0[2], C0[3], C1[1]); a = MX3(a, C1[2], C1[3]); \
      _Pragma("unroll") for (int r = 4; r < 16; r += 4) { a = MX3(a, C0[r], C0[r + 1]); b = MX3(b, C0[r + 2], C0[r + 3]); a = MX3(a, C1[r], C1[r + 1]); b = MX3(b, C1[r + 2], C1[r + 3]); } \
      float rm = __builtin_fmaxf(a, b); { auto rr = __builtin_amdgcn_permlane32_swap(__float_as_uint(rm), __float_as_uint(rm), false, false); rm = __builtin_fmaxf(__uint_as_float(rr[0]), __uint_as_float(rr[1])); } \
      resc = false; \
      if (__builtin_expect(__any(rm > (float)THRL), 0)) { const float dl = __builtin_fmaxf(rm, 0.f); mhat += dl; \
        _Pragma("unroll") for (int r = 0; r < 16; ++r) { C0[r] -= dl; C1[r] -= dl; } \
        _Pragma("unroll") for (int r = 0; r < 16; ++r) negm[r] = -mhat; asm volatile("" : "+v"(negm)); \
        const float f = __builtin_amdgcn_exp2f(-dl); l_reg *= f; if (hi == 0) wsf[r32] = f; resc = true; } } \
    SBAR(); \
    GAPB(0, PAF(0), C0, 0);  GAPB(1, PAF(0), C0, 2);  GAPB(2, PAF(0), C0, 4);  GAPB(3, PAF(0), C0, 6); \
    GAPB(4, PAF(1), C0, 8);  GAPB(5, PAF(1), C0, 10); GAPB(6, PAF(1), C0, 12); GAPB(7, PAF(1), C0, 14); \
    GAPB(8, PAF(2), C1, 0);  GAPB(9, PAF(2), C1, 2);  GAPB(10, PAF(2), C1, 4); GAPB(11, PAF(2), C1, 6); \
    if (GL) { kf[0] = kfrag(kp0 + ks_next, 0); kf[1] = kfrag(kp0 + ks_next, 1); SBAR(); } \
    GAPB(12, PAF(3), C1, 8); GAPB(13, PAF(3), C1, 10); GAPB(14, PAF(3), C1, 12); GAPB(15, PAF(3), C1, 14); \
    } while (0)
    int t = 1;
#undef CMASK
#define CMASK(P0, P1, t) do { } while (0)
    for (; t + 5 < NT; t += 2) {
        STEP(pB0, pB1, pA0, pA1, t, true, true, true);     WAIT_BAR(3); RESC(); ROT();
        STEP(pA0, pA1, pB0, pB1, t + 1, true, true, true); WAIT_BAR(3); RESC(); ROT();
    }
#undef CMASK
#define CMASK(P0, P1, t) do { int jb_ = (t) - (NT - 4); if (jb_ >= 0) cmask(P0, P1, jb_, qrel, hi); } while (0)
#define ENDW(tt) do { if ((tt) + 3 < NT) { WAIT_BAR(3); } else if ((tt) + 1 < NT) { WAIT_BAR(2); } else { WAIT_BAR(0); } } while (0)
    for (; t + 1 < NT; t += 2) {
        STEP(pB0, pB1, pA0, pA1, t, (t + 3 < NT), (t + 1 < NT), (t + 1 < NT));         ENDW(t);     RESC(); ROT();
        STEP(pA0, pA1, pB0, pB1, t + 1, (t + 4 < NT), (t + 2 < NT), (t + 2 < NT));     ENDW(t + 1); RESC(); ROT();
    }
    { float sacc = pA0[0] + pA0[1]; _Pragma("unroll") for (int r = 2; r < 16; ++r) sacc += pA0[r]; _Pragma("unroll") for (int r = 0; r < 16; ++r) sacc += pA1[r]; l_reg += sacc;
      pw0 = (u32x4){PKW(pA0, 0), PKW(pA0, 2), PKW(pA0, 4), PKW(pA0, 6)}; pw1 = (u32x4){PKW(pA0, 8), PKW(pA0, 10), PKW(pA0, 12), PKW(pA0, 14)}; pw2 = (u32x4){PKW(pA1, 0), PKW(pA1, 2), PKW(pA1, 4), PKW(pA1, 6)}; pw3 = (u32x4){PKW(pA1, 8), PKW(pA1, 10), PKW(pA1, 12), PKW(pA1, 14)};
      const lds_cptr vp_ = vp0 + vs_prev;
#pragma unroll
      for (int dq = 0; dq < 4; ++dq) {
          VRD(dq * 4 + 0); VRD(dq * 4 + 1); VRD(dq * 4 + 2); VRD(dq * 4 + 3);
          o[dq] = __builtin_amdgcn_mfma_f32_32x32x16_bf16(PAF(0), VFR(dq * 4 + 0), o[dq], 0, 0, 0);
          o[dq] = __builtin_amdgcn_mfma_f32_32x32x16_bf16(PAF(1), VFR(dq * 4 + 1), o[dq], 0, 0, 0);
          o[dq] = __builtin_amdgcn_mfma_f32_32x32x16_bf16(PAF(2), VFR(dq * 4 + 2), o[dq], 0, 0, 0);
          o[dq] = __builtin_amdgcn_mfma_f32_32x32x16_bf16(PAF(3), VFR(dq * 4 + 3), o[dq], 0, 0, 0); } }
#undef PKW
#undef PAF
#undef VFR
#undef PIN
#undef MX3
#undef EX
#undef VIX
#undef VRD
#undef KRD
#undef GAPA
#undef GAPB
#undef STEP
#undef ENDW
#undef DMA_K
#undef DMA_V
#undef CMASK
#undef RESC
#undef ROT
    { auto rr = __builtin_amdgcn_permlane32_swap(__float_as_uint(l_reg), __float_as_uint(l_reg), false, false); l_reg = __uint_as_float(rr[0]) + __uint_as_float(rr[1]); }
    l_out = l_reg;
    asm volatile("s_waitcnt lgkmcnt(0)\n\ts_barrier" ::: "memory");
}
__device__ __forceinline__ void attn_unit(int qb, int b, int h, const bf16_t* Qb, const bf16_t* Kb, const bf16_t* Vb, bf16_t* OA, float lam, char* shm) {
    int tid = threadIdx.x; asm volatile("" : "+v"(tid));
    const int lane = tid & 63, r32 = lane & 31, hi = lane >> 5; const int wid = __builtin_amdgcn_readfirstlane(tid >> 6);
    float* wsf = (float*)(shm + LDS_WS) + wid * 64;
    bf16_t* stg = (bf16_t*)(shm + LDS_OST) + wid * 4096;
    bf16_t* sl = stg + hi * 512 + r32;
    const float* wl = wsf + 32 + 4 * hi;
#define CR(r) (((r) & 3) + 8 * ((r) >> 2))
    const long row0 = (long)b * SEQ + qb * 256;
    f32x16 o[4]; float l_reg;
#pragma unroll 1
    for (int c = 0; c < 2; ++c) {
        const int hc = 2 * h + c;
        attn_pass<8>(qb, Qb + row0 * D + hc * 64, Kb + (long)META0 * D + hc * 64, Kb + (long)b * SEQ * D + hc * 64, Vb + (long)META0 * D + h * 128, Vb + (long)b * SEQ * D + h * 128, o, l_reg, shm);
        if (hi == 0) wsf[32 + r32] = l_reg; asm volatile("s_waitcnt lgkmcnt(0)" ::: "memory");
        if (c == 0) {
#pragma unroll
            for (int r = 0; r < 16; ++r) { const float rl = __builtin_amdgcn_rcpf(wl[CR(r)]);
#pragma unroll
                for (int d = 0; d < 4; ++d) sl[CR(r) * 128 + d * 32] = f2bf(o[d][r] * rl); }
            asm volatile("s_waitcnt lgkmcnt(0)" ::: "memory");
        } else {
            float ps[16];
#pragma unroll
            for (int r = 0; r < 16; ++r) { const float rl = lam * __builtin_amdgcn_rcpf(wl[CR(r)]); float s = 0.f;
#pragma unroll
                for (int d = 0; d < 4; ++d) { const float v = bf2f(sl[CR(r) * 128 + d * 32]) - o[d][r] * rl; o[d][r] = v; s += v * v; }
                ps[r] = s; }
#pragma unroll
            for (int r = 0; r < 16; ++r) { float s = ps[r]; s += __shfl_xor(s, 1); s += __shfl_xor(s, 2); s += __shfl_xor(s, 4); s += __shfl_xor(s, 8); s += __shfl_xor(s, 16); ps[r] = 1.0f / sqrtf(s * (1.f / 128.f) + SUBLN_EPS); }
            asm volatile("s_waitcnt lgkmcnt(0)" ::: "memory");
#pragma unroll
            for (int r = 0; r < 16; ++r) {
#pragma unroll
                for (int d = 0; d < 4; ++d) sl[CR(r) * 128 + d * 32] = f2bf(o[d][r] * ps[r]); }
            asm volatile("s_waitcnt lgkmcnt(0)" ::: "memory");
            int l2 = lane; asm volatile("" : "+v"(l2));
            bf16_t* Ow = OA + (row0 + wid * QBLK + (l2 >> 4)) * D + h * 128 + (l2 & 15) * 8; const bf16_t* sr = stg + (l2 >> 4) * 128 + (l2 & 15) * 8;
#pragma unroll
            for (int i = 0; i < 8; ++i) { const u32x4 v = *(const u32x4*)(sr + i * 512); *(u32x4*)(Ow + (long)i * 4 * D) = v; }
            asm volatile("s_waitcnt lgkmcnt(0)" ::: "memory");
        }
    }
#undef CR
}
#undef SBAR
#undef WAIT_BAR
}
__device__ __forceinline__ void p9_attn2(Frame& F, bf16_t* OA) {
    const bf16_t* Kb = F.wsb(WS_X); const bf16_t* Vb = F.wsb(WS_X + ROWBUF); const bf16_t* Qb = F.wsb(WS_X + 2 * ROWBUF);
    const float lam = lambda_full(F);
    const int G = (int)gridDim.x; const int vcu = (G % 8 == 0) ? ((int)blockIdx.x % 8) * (G / 8) + (int)blockIdx.x / 8 : (int)blockIdx.x;
    for (int p = vcu; p < BATCH * 8 * 2; p += G) {
        const int bh = p >> 1, s = p & 1, b = bh >> 3, h = bh & 7;
#pragma unroll 1
        for (int i = 0; i < 4; ++i) {
            const int qb = s == 0 ? (i == 0 ? 7 : (i == 1 ? 0 : (i == 2 ? 5 : 2))) : (i == 0 ? 6 : (i == 1 ? 1 : (i == 2 ? 4 : 3)));
            att2::attn_unit(qb, b, h, Qb, Kb, Vb, OA, lam, (char*)F.lds);
        }
    }
}

constexpr int NPH = 14;
#ifndef DUP_MASK
#define DUP_MASK 0
#endif
#ifndef MK_PER_PHASE
#define MK_PER_PHASE 0
#endif
#ifndef DUP_MASK
#define DUP_MASK 0
#endif
#ifndef DRY_MODE
#define DRY_MODE 3
#endif
__global__ void __launch_bounds__(NTHR, 2) fwd(Args args) {
    extern __shared__ __attribute__((aligned(16))) unsigned char lds_raw[];
    Frame F;
    F.lds = (LAS unsigned char*)lds_raw;
    F.tid = threadIdx.x; F.wave = __builtin_amdgcn_readfirstlane(F.tid >> 6);
    F.gw = blockIdx.x * NWAVES + F.wave; F.ngw = gridDim.x * NWAVES;
    F.ws = args.ws; F.out = args.out; F.ctl = (unsigned*)(args.ws + WS_CTL);
#pragma unroll
    for (int i = 0; i < 22; ++i) F.in[i] = args.in[i];
    volatile LAS unsigned* MISC = (volatile LAS unsigned*)(F.lds + MISC_OFF);
    if (F.tid < 64) MISC[F.tid] = 0u;
    __syncthreads();
    XcdBarrier bar; bar.bar = F.ctl + CW_BAR; bar.x = 0; bar.st = nullptr;
    if (!MK_PER_PHASE) bar = xcd_barrier_post(F.ctl + CW_BAR, MISC + 8);
    const int lo = args.ph_lo, hi = args.ph_hi;
#define IN(k) (lo <= (k) && (k) < hi)
#define SEAM(k) do { if (IN(k) && IN((k) + 1)) xcd_barrier(bar); } while (0)
    unsigned* cnt0 = F.ctl + CW_CNT0; unsigned* cnt1 = F.ctl + CW_CNT1; float* ssq = (float*)(F.ws + WS_MISC + MISC_SSQ);
    bf16_t* OA = F.wsb(WS_X + 2 * ROWBUF);
    bf16_t* O0 = (bf16_t*)F.out; bf16_t* O1 = (bf16_t*)F.out + (size_t)MMAIN * D;
    const int dry = args.pad;
    if (IN(0)) { p0_prologue(F); } SEAM(0);
    if (IN(1)) { p1_opt(F); } SEAM(1);
    if (IN(2)) { p2_conv(F); } SEAM(2);
    if (IN(3)) { p3_opt(F); } SEAM(3);
    if (IN(4)) { p_router(F, 0, NTOK0, F.rstd(1), cnt0, dry); } SEAM(4);
    if (IN(5)) { m1_run<(FP8_M1_MASK & 1) != 0, (FP8_MASK & 1) != 0>(F, 0, F.rstd(1), cnt0); } SEAM(5);
    if (IN(6)) { m2_run<(FP8_MASK & 1) != 0>(F, 0, cnt0, dry, ssq, nullptr); } SEAM(6);
    if (IN(7)) { p8_opt(F, ssq); } SEAM(7);
    if (IN(8)) { p9_attn2(F, OA); } SEAM(8);
    if (IN(9)) { p10_opt(F, OA, dry); } SEAM(9);
    if (IN(10)) { p_router(F, 1, MMAIN, F.rstd(3), cnt1, dry); } SEAM(10);
    if (IN(11)) { m1_run<(FP8_M1_MASK & 2) != 0, (FP8_MASK & 2) != 0>(F, 1, F.rstd(3), cnt1); } SEAM(11);
    if (IN(12)) { m2_run<(FP8_MASK & 2) != 0>(F, 1, cnt1, dry, nullptr, nullptr); } SEAM(12);
    if (IN(13)) { p_final(F, dry); }
#undef IN
#undef SEAM
}

extern "C" void kernel_launch(void* const* d_in, const int* in_sizes, int n_in, void* d_out, int out_size, void* d_ws, size_t ws_size, hipStream_t stream) {
    static int grid = 0;
    if (grid == 0) {
        int dev = 0, cus = 0;
        if (hipGetDevice(&dev) != hipSuccess || hipDeviceGetAttribute(&cus, hipDeviceAttributeMultiprocessorCount, dev) != hipSuccess) { grid = -1; return; }
        if (hipFuncSetAttribute((const void*)fwd, hipFuncAttributeMaxDynamicSharedMemorySize, LDS_BYTES) != hipSuccess) { fprintf(stderr, "kernel_launch: hipFuncSetAttribute failed\n"); grid = -1; return; }
        int per_cu = 0;
        if (hipOccupancyMaxActiveBlocksPerMultiprocessor(&per_cu, (const void*)fwd, NTHR, LDS_BYTES) != hipSuccess || per_cu < 1) fprintf(stderr, "kernel_launch: occupancy query says %d\n", per_cu);
        (void)hipGetLastError();
        grid = cus;
        if (n_in != 22 || ws_size < WS_END) { fprintf(stderr, "kernel_launch: unexpected n_in %d / ws_size %zu\n", n_in, ws_size); grid = -1; return; }
    }
    if (grid < 0) return;
    (void)hipMemsetAsync((char*)d_ws + WS_CTL, 0, CTL_BYTES, stream);
    Args a{};
    for (int i = 0; i < 22; ++i) a.in[i] = (const float*)d_in[i];
    a.out = (float*)d_out; a.ws = (unsigned char*)d_ws; a.pad = 0;
#if MK_PER_PHASE
    for (int p = 0; p < NPH; ++p) { a.ph_lo = p; a.ph_hi = p + 1; a.li = p;
        if ((DUP_MASK >> p) & 1) { a.pad = DRY_MODE; hipLaunchKernelGGL(fwd, dim3(grid), dim3(NTHR), LDS_BYTES, stream, a); a.pad = 0; }
        hipLaunchKernelGGL(fwd, dim3(grid), dim3(NTHR), LDS_BYTES, stream, a); }
#else
    a.ph_lo = 0; a.ph_hi = NPH; a.li = 0;
    hipLaunchKernelGGL(fwd, dim3(grid), dim3(NTHR), LDS_BYTES, stream, a);
#endif
}
```
